# Optimizing an MI355X kernel written in HIP

```python
import math
import jax, jax.numpy as jnp
from jax import lax
import numpy as np

D_MODEL = 1024
BATCH = 4
SEQ = 4096
DEPTH = 2

N_MOD = 6
EPS = 1e-6
SSM_EXPAND = 2
SSM_D_INNER = SSM_EXPAND * D_MODEL
SSM_HEAD_DIM = 64
SSM_HEADS = SSM_D_INNER // SSM_HEAD_DIM
SSM_GROUPS = 4
SSM_STATE = 128
SSM_CONV = 4
SSM_CHUNK = 128
SSM_CONV_DIM = SSM_D_INNER + 2 * SSM_GROUPS * SSM_STATE
ATT_HEAD_DIM = 64
ATT_KV_HEADS = D_MODEL // ATT_HEAD_DIM
ATT_PATTERNS = ((128, 1), (512, 4), (2048, 16))
ATT_GROUPS = len(ATT_PATTERNS)
ATT_Q_HEADS = ATT_GROUPS * ATT_KV_HEADS
ATT_WIDTH = ATT_KV_HEADS * ATT_HEAD_DIM
REL_BUCKETS = 32
REL_MAX_DIST = 2048
HY_SIZES = (SSM_D_INNER, SSM_CONV_DIM, SSM_HEADS, ATT_Q_HEADS * ATT_HEAD_DIM, ATT_WIDTH, ATT_WIDTH)
HY_SPLITS = tuple(int(v) for v in np.cumsum(HY_SIZES)[:-1])
HY_IN_DIM = sum(HY_SIZES)
HY_OUT_DIM = SSM_D_INNER + ATT_WIDTH
CONV_WIDTH = 31
FFN_HIDDEN = -(-8 * D_MODEL // (3 * 256)) * 256
N_EVEN = (DEPTH + 1) // 2
N_ODD = DEPTH // 2

kernel_name = "hybrid_ssd_dilated_conformer_block"


def rms_norm(x, g):
    xf = x.astype(jnp.float32)
    y = xf * lax.rsqrt(jnp.mean(xf * xf, -1, keepdims=True) + EPS)
    return (y * g.astype(jnp.float32)).astype(x.dtype)


def layer_norm(x, g, b):
    xf = x.astype(jnp.float32)
    mu = jnp.mean(xf, -1, keepdims=True)
    var = jnp.mean(jnp.square(xf - mu), -1, keepdims=True)
    y = (xf - mu) * lax.rsqrt(var + EPS)
    return (y * g.astype(jnp.float32) + b.astype(jnp.float32)).astype(x.dtype)


def causal_depthwise_conv(x, w, b):
    k = w.shape[0]
    out = lax.conv_general_dilated(
        x, w[:, None, :].astype(x.dtype), window_strides=(1,), padding=[(k - 1, 0)],
        dimension_numbers=('NWC', 'WIO', 'NWC'), feature_group_count=x.shape[-1])
    return out + b


def t5_bucket(dist):
    max_exact = REL_BUCKETS // 2
    n = jnp.maximum(dist, 1).astype(jnp.float32)
    large = max_exact + jnp.log(n / max_exact) / math.log(REL_MAX_DIST / max_exact) * (REL_BUCKETS - max_exact)
    large = jnp.minimum(large.astype(jnp.int32), REL_BUCKETS - 1)
    return jnp.where(dist < max_exact, dist, large)


def ssd_chunked(x, dt, A, Bm, Cm):
    f32 = jnp.float32
    b_, s, h, p = x.shape
    g, n = Bm.shape[2], Bm.shape[3]
    r, q = h // g, SSM_CHUNK
    nc = s // q
    x = x.astype(f32).reshape(b_, nc, q, g, r, p)
    dt = dt.astype(f32).reshape(b_, nc, q, g, r)
    Bm = Bm.astype(f32).reshape(b_, nc, q, g, n)
    Cm = Cm.astype(f32).reshape(b_, nc, q, g, n)
    a_cs = jnp.cumsum(dt * A.astype(f32).reshape(g, r), axis=2)
    xdt = x * dt[..., None]
    seg = a_cs[:, :, :, None] - a_cs[:, :, None, :]
    causal = jnp.tril(jnp.ones((q, q), bool))[:, :, None, None]
    decay = jnp.exp(jnp.where(causal, seg, -jnp.inf))
    cb = jnp.einsum('bclgn,bcsgn->bclsg', Cm, Bm)
    y_diag = jnp.einsum('bclsgr,bcsgrp->bclgrp', cb[..., None] * decay, xdt)
    decay_end = jnp.exp(a_cs[:, :, -1:] - a_cs)
    states = jnp.einsum('bcsgn,bcsgrp->bcgrpn', Bm, xdt * decay_end[..., None])
    chunk_decay = jnp.exp(a_cs[:, :, -1])

    def step(hs, inp):
        st, dec = inp
        return dec[..., None, None] * hs + st, hs

    h0 = jnp.zeros((b_, g, r, p, n), f32)
    _, prev = lax.scan(step, h0, (jnp.moveaxis(states, 1, 0), jnp.moveaxis(chunk_decay, 1, 0)))
    prev = jnp.moveaxis(prev, 0, 1)
    y_off = jnp.einsum('bclgn,bcgrpn->bclgrp', Cm, prev) * jnp.exp(a_cs)[..., None]
    return (y_diag + y_off).reshape(b_, s, h, p)


def dilated_branch(q, k, v, bias_tab, window, dil):
    b_, s, h, dh = q.shape
    blk = window // dil
    L = s // dil
    nb = -(-L // blk)
    lp = nb * blk

    def blocks(t):
        t = t.reshape(b_, L, dil, h, dh)
        t = jnp.pad(t, ((0, 0), (0, lp - L), (0, 0), (0, 0), (0, 0)))
        return t.reshape(b_, nb, blk, dil, h, dh)

    def band_keys(t):
        prev = jnp.pad(t, ((0, 0), (1, 0), (0, 0), (0, 0), (0, 0), (0, 0)))[:, :-1]
        return jnp.concatenate([prev, t], axis=2)

    qb = blocks(q)
    kw, vw = band_keys(blocks(k)), band_keys(blocks(v))
    i = jnp.arange(blk)[:, None]
    j = jnp.arange(2 * blk)[None, :]
    delta = blk + i - j
    band = (delta >= 0) & (delta <= blk)
    kpos = jnp.arange(nb)[:, None] * blk + jnp.arange(2 * blk)[None, :] - blk
    mask = band[None] & (kpos >= 0)[:, None, :]
    bias = jnp.transpose(bias_tab[t5_bucket(jnp.maximum(delta, 0) * dil)], (2, 0, 1)).astype(jnp.float32)
    sc = jnp.einsum('bnirhd,bnjrhd->bnrhij', qb, kw).astype(jnp.float32) * (dh ** -0.5) + bias
    sc = jnp.where(mask[None, :, None, None], sc, -jnp.inf)
    m = jnp.max(sc, -1, keepdims=True)
    pr = jnp.exp(sc - m)
    l = jnp.sum(pr, -1, keepdims=True)
    o = jnp.einsum('bnrhij,bnjrhd->bnirhd', (pr / l).astype(v.dtype), vw)
    lse = jnp.transpose((m + jnp.log(l))[..., 0], (0, 1, 4, 2, 3))
    lse = lse.reshape(b_, lp, dil, h)[:, :L].reshape(b_, s, h)
    o = o.reshape(b_, lp, dil, h, dh)[:, :L].reshape(b_, s, h, dh)
    return o, lse


def dilated_attention(q, k, v, rel_table):
    b_, s, _, h, dh = q.shape
    outs, lses = [], []
    for gi, (w, d) in enumerate(ATT_PATTERNS):
        o, lse = dilated_branch(q[:, :, gi], k, v, rel_table[:, gi * h:(gi + 1) * h], w, d)
        outs.append(o)
        lses.append(lse)
    wgt = jax.nn.softmax(jnp.stack(lses, 0), axis=0)
    o = jnp.einsum('gbsh,gbshd->bshd', wgt.astype(outs[0].dtype), jnp.stack(outs, 0))
    return o.reshape(b_, s, h * dh)


def hybrid_mixer(h, w_in, conv_w, conv_b, dt_bias, a_log, d_skip, ssm_norm_g, w_out, rel_table):
    b_, s, _ = h.shape
    z, xbc, dt_raw, q, k, v = jnp.split(h @ w_in, HY_SPLITS, axis=-1)
    xbc = jax.nn.silu(causal_depthwise_conv(xbc, conv_w, conv_b))
    xs, bm, cm = jnp.split(xbc, (SSM_D_INNER, SSM_D_INNER + SSM_GROUPS * SSM_STATE), axis=-1)
    xs = xs.reshape(b_, s, SSM_HEADS, SSM_HEAD_DIM)
    dt = jax.nn.softplus((dt_raw + dt_bias).astype(jnp.float32))
    A = -jnp.exp(a_log.astype(jnp.float32))
    y = ssd_chunked(xs, dt, A, bm.reshape(b_, s, SSM_GROUPS, SSM_STATE), cm.reshape(b_, s, SSM_GROUPS, SSM_STATE))
    y = y + d_skip.astype(jnp.float32)[:, None] * xs.astype(jnp.float32)
    y = y.reshape(b_, s, SSM_D_INNER).astype(h.dtype)
    y = rms_norm(y * jax.nn.silu(z), ssm_norm_g)
    att = dilated_attention(q.reshape(b_, s, ATT_GROUPS, ATT_KV_HEADS, ATT_HEAD_DIM),
                            k.reshape(b_, s, ATT_KV_HEADS, ATT_HEAD_DIM),
                            v.reshape(b_, s, ATT_KV_HEADS, ATT_HEAD_DIM), rel_table)
    return jnp.concatenate([y, att.astype(y.dtype)], axis=-1) @ w_out


def conformer_conv(h, w1, b1, w_dw, b_dw, ln_g, ln_b, w2, b2):
    a, gt = jnp.split(h @ w1 + b1, 2, axis=-1)
    u = a * jax.nn.sigmoid(gt)
    u = causal_depthwise_conv(u, w_dw, b_dw)
    u = jax.nn.silu(layer_norm(u, ln_g, ln_b))
    return u @ w2 + b2


def swiglu(h, wg, wu, wd):
    return (jax.nn.silu(h @ wg) * (h @ wu)) @ wd


def setup_inputs(seed: int = 0) -> dict:
    key = jax.random.key(seed)
    ks = iter(jax.random.split(key, 40))
    f32 = jnp.float32

    def nrm(shape, scale=1.0):
        return jax.random.normal(next(ks), shape, f32) * scale

    D = D_MODEL
    dt0 = jnp.exp(jax.random.uniform(next(ks), (N_EVEN, SSM_HEADS), f32, math.log(1e-3), math.log(1e-1)))
    return {
        "x": nrm((BATCH, SEQ, D)),
        "c": nrm((BATCH, D)),
        "ada_w": nrm((DEPTH, D, N_MOD * D), 0.5 * D ** -0.5),
        "ada_b": nrm((DEPTH, N_MOD * D), 0.02),
        "norm_mix_g": 1.0 + nrm((DEPTH, D), 0.05),
        "norm_ffn_g": 1.0 + nrm((DEPTH, D), 0.05),
        "hy_w_in": nrm((N_EVEN, D, HY_IN_DIM), D ** -0.5),
        "hy_conv_w": nrm((N_EVEN, SSM_CONV, SSM_CONV_DIM), SSM_CONV ** -0.5),
        "hy_conv_b": nrm((N_EVEN, SSM_CONV_DIM), 0.02),
        "hy_dt_bias": dt0 + jnp.log(-jnp.expm1(-dt0)),
        "hy_a_log": jnp.log(jax.random.uniform(next(ks), (N_EVEN, SSM_HEADS), f32, 1.0, 16.0)),
        "hy_d_skip": 1.0 + nrm((N_EVEN, SSM_HEADS), 0.1),
        "hy_ssm_norm_g": 1.0 + nrm((N_EVEN, SSM_D_INNER), 0.05),
        "hy_w_out": nrm((N_EVEN, HY_OUT_DIM, D), HY_OUT_DIM ** -0.5),
        "rel_table": nrm((REL_BUCKETS, ATT_Q_HEADS), 0.2),
        "cv_w_pw1": nrm((N_ODD, D, 2 * D), D ** -0.5),
        "cv_b_pw1": nrm((N_ODD, 2 * D), 0.02),
        "cv_w_dw": nrm((N_ODD, CONV_WIDTH, D), CONV_WIDTH ** -0.5),
        "cv_b_dw": nrm((N_ODD, D), 0.02),
        "cv_ln_g": 1.0 + nrm((N_ODD, D), 0.05),
        "cv_ln_b": nrm((N_ODD, D), 0.02),
        "cv_w_pw2": nrm((N_ODD, D, D), D ** -0.5),
        "cv_b_pw2": nrm((N_ODD, D), 0.02),
        "ffn_w_gate": nrm((DEPTH, D, FFN_HIDDEN), D ** -0.5),
        "ffn_w_up": nrm((DEPTH, D, FFN_HIDDEN), D ** -0.5),
        "ffn_w_down": nrm((DEPTH, FFN_HIDDEN, D), FFN_HIDDEN ** -0.5),
        "final_norm_g": 1.0 + nrm((D,), 0.05),
    }


def reference(x, c, ada_w, ada_b, norm_mix_g, norm_ffn_g, hy_w_in, hy_conv_w, hy_conv_b, hy_dt_bias,
              hy_a_log, hy_d_skip, hy_ssm_norm_g, hy_w_out, rel_table, cv_w_pw1, cv_b_pw1, cv_w_dw,
              cv_b_dw, cv_ln_g, cv_ln_b, cv_w_pw2, cv_b_pw2, ffn_w_gate, ffn_w_up, ffn_w_down,
              final_norm_g):
    cs = jax.nn.silu(c)
    for i in range(DEPTH):
        mod = cs @ ada_w[i] + ada_b[i]
        sh1, sc1, g1, sh2, sc2, g2 = [m[:, None, :] for m in jnp.split(mod, N_MOD, axis=-1)]
        h = rms_norm(x, norm_mix_g[i]) * (1 + sc1) + sh1
        j = i // 2
        if i % 2 == 0:
            mix = hybrid_mixer(h, hy_w_in[j], hy_conv_w[j], hy_conv_b[j], hy_dt_bias[j], hy_a_log[j],
                               hy_d_skip[j], hy_ssm_norm_g[j], hy_w_out[j], rel_table)
        else:
            mix = conformer_conv(h, cv_w_pw1[j], cv_b_pw1[j], cv_w_dw[j], cv_b_dw[j], cv_ln_g[j],
                                 cv_ln_b[j], cv_w_pw2[j], cv_b_pw2[j])
        x = x + g1 * mix
        h = rms_norm(x, norm_ffn_g[i]) * (1 + sc2) + sh2
        x = x + g2 * swiglu(h, ffn_w_gate[i], ffn_w_up[i], ffn_w_down[i])
    return rms_norm(x, final_norm_g)
```

```cpp
#include <hip/hip_runtime.h>
#include <cstdio>
#include <cstdint>

__device__ __forceinline__ int lane_id() { int l; asm volatile("v_mbcnt_lo_u32_b32 %0, -1, 0\n\tv_mbcnt_hi_u32_b32 %0, -1, %0" : "=v"(l)); return l; }
namespace pg8 {
#define PG8_LAS __attribute__((address_space(3)))
typedef unsigned short bf16_t;
typedef short bf16x8 __attribute__((ext_vector_type(8)));
typedef float f32x4 __attribute__((ext_vector_type(4)));
typedef unsigned u32x4 __attribute__((ext_vector_type(4)));
constexpr int BM = 256, BK = 64, HALF = 128, HTB = HALF * BK * 2, STAGE_BYTES = 8 * HTB, NXCD = 8, WGM = 8;

__host__ __device__ __forceinline__ int lds_byte(int r, int c) { const int st = (r >> 4) * 2 + (c >> 5), rr = r & 15, cc = c & 31, ob = rr * 64 + cc * 2; return st * 1024 + (ob ^ (((ob >> 9) & 1) << 5)); }
__host__ __device__ __forceinline__ void stage_rc(int b, int& R, int& C) { const int st = b / 1024, sb = b % 1024, swz = sb ^ (((sb >> 9) & 1) << 5); R = (st >> 1) * 16 + swz / 64; C = (st & 1) * 32 + (swz % 64) / 2; }
__host__ __device__ __forceinline__ int perm32(int rho) { const int n = rho >> 4, i = rho & 15; return 8 * (i >> 2) + 4 * n + (i & 3); }

struct Unit { int pm, pn; };
struct Gemm { const bf16_t* A; const bf16_t* Bt; int M, N, K; };

struct StaticOrder {
    int nM, nN, nwg, G, c;
    __host__ __device__ void init(int M, int N, int G_, int c_) { nM = M / BM; nN = N / BM; nwg = nM * nN; G = G_; c = c_; }
    __host__ __device__ bool next(int i, Unit& u) const {
        const long L = (long)i * G + c; if (L >= nwg) return false;
        int wgid = (int)L; { const int q = nwg / NXCD, r = nwg % NXCD, xcd = wgid % NXCD, off = wgid / NXCD; wgid = (xcd < r ? xcd * (q + 1) : r * (q + 1) + (xcd - r) * q) + off; }
        const int nig = WGM * nN, gid = wgid / nig, fm = gid * WGM, gsz = (nM - fm) < WGM ? (nM - fm) : WGM;
        u.pm = fm + ((wgid % nig) % gsz); u.pn = (wgid % nig) / gsz; return true;
    }
    __device__ __forceinline__ void a_ready(const Unit&) const {}
    __device__ __forceinline__ void done(const Unit&) const {}
};

__device__ __forceinline__ unsigned cvt_pk_bf16(float lo, float hi) { unsigned r; asm volatile("v_cvt_pk_bf16_f32 %0, %1, %2" : "=v"(r) : "v"(lo), "v"(hi)); return r; }

struct EpiBf16Seg {
    static constexpr bool PERM = true, AFTER_DRAIN = false;
    bf16_t* O0; int ld0; int t1; bf16_t* O1; int ld1; int t2; bf16_t* O2; int ld2;
    __device__ __forceinline__ void operator()(const f32x4 (&acc)[2][2][4][2], const Unit& u, int wr, int wc, int fr, int fq) const {
        bf16_t* base; int ld, ct;
        if (u.pn < t1) { base = O0; ld = ld0; ct = u.pn; } else if (u.pn < t2) { base = O1; ld = ld1; ct = u.pn - t1; } else { base = O2; ld = ld2; ct = u.pn - t2; }
        const int row0 = u.pm * BM + wr * 64 + fr, col0 = ct * BM + wc * 32 + 8 * fq;
#pragma unroll
        for (int ai = 0; ai < 2; ++ai)
#pragma unroll
            for (int m = 0; m < 4; ++m) { bf16_t* rowp = base + (size_t)(row0 + ai * HALF + m * 16) * ld + col0;
#pragma unroll
                for (int bj = 0; bj < 2; ++bj) { const f32x4 v0 = acc[ai][bj][m][0], v1 = acc[ai][bj][m][1];
                    u32x4 w; w.x = cvt_pk_bf16(v0[0], v0[1]); w.y = cvt_pk_bf16(v0[2], v0[3]); w.z = cvt_pk_bf16(v1[0], v1[1]); w.w = cvt_pk_bf16(v1[2], v1[3]);
                    *(u32x4*)(rowp + bj * HALF) = w; } }
    }
};
__device__ __forceinline__ float sigm(float v) { return __builtin_amdgcn_rcpf(1.0f + __builtin_amdgcn_exp2f(-1.4426950408889634f * v)); }
template <int MODE> struct EpiGate {
    static constexpr bool PERM = true, AFTER_DRAIN = false;
    bf16_t* O; int ldc; const float* ba; const float* bg;
    __device__ __forceinline__ void operator()(const f32x4 (&acc)[2][2][4][2], const Unit& u, int wr, int wc, int fr, int fq) const {
        const int row0 = u.pm * BM + wr * 64 + fr, col0 = u.pn * HALF + wc * 32 + 8 * fq;
        f32x4 bav[2], bgv[2];
#pragma unroll
        for (int n = 0; n < 2; ++n) { if (MODE == 1) { bav[n] = *(const f32x4*)(ba + col0 + 4 * n); bgv[n] = *(const f32x4*)(bg + col0 + 4 * n); } else { bav[n] = (f32x4){0.f, 0.f, 0.f, 0.f}; bgv[n] = bav[n]; } }
#pragma unroll
        for (int ai = 0; ai < 2; ++ai)
#pragma unroll
            for (int m = 0; m < 4; ++m) { bf16_t* rowp = O + (size_t)(row0 + ai * HALF + m * 16) * ldc + col0; float r[8];
#pragma unroll
                for (int n = 0; n < 2; ++n)
#pragma unroll
                    for (int j = 0; j < 4; ++j) { const float a = acc[ai][0][m][n][j] + bav[n][j], b = acc[ai][1][m][n][j] + bgv[n][j];
                        r[4 * n + j] = (MODE == 0) ? a * sigm(a) * b : a * sigm(b); }
                u32x4 w; w.x = cvt_pk_bf16(r[0], r[1]); w.y = cvt_pk_bf16(r[2], r[3]); w.z = cvt_pk_bf16(r[4], r[5]); w.w = cvt_pk_bf16(r[6], r[7]);
                *(u32x4*)rowp = w; }
    }
};
struct EpiRes {
    static constexpr bool PERM = false, AFTER_DRAIN = false;
    const float* base; float* out; const float* gate; const float* bias;
    __device__ __forceinline__ void operator()(const f32x4 (&acc)[2][2][4][2], const Unit& u, int wr, int wc, int fr, int fq) const {
        const int row0 = u.pm * BM + wr * 64 + fr, col0 = u.pn * BM + wc * 32 + 4 * fq;
        const float* gp = gate + (size_t)(u.pm >> 4) * 6144 + col0;
        f32x4 gv[2][2], bv[2][2];
#pragma unroll
        for (int bj = 0; bj < 2; ++bj)
#pragma unroll
            for (int n = 0; n < 2; ++n) { gv[bj][n] = *(const f32x4*)(gp + bj * HALF + n * 16); bv[bj][n] = bias ? *(const f32x4*)(bias + col0 + bj * HALF + n * 16) : (f32x4){0.f, 0.f, 0.f, 0.f}; }
#pragma unroll
        for (int ai = 0; ai < 2; ++ai)
#pragma unroll
            for (int m = 0; m < 4; ++m) { const size_t off = (size_t)(row0 + ai * HALF + m * 16) * 1024 + col0;
#pragma unroll
                for (int bj = 0; bj < 2; ++bj)
#pragma unroll
                    for (int n = 0; n < 2; ++n) { const f32x4 bs = *(const f32x4*)(base + off + bj * HALF + n * 16);
                        *(f32x4*)(out + off + bj * HALF + n * 16) = bs + gv[bj][n] * (acc[ai][bj][m][n] + bv[bj][n]); }
                if (m & 1) asm volatile("" ::: "memory"); }
    }
};

template <class Epi, class Sched, bool ALIGN_EPI = false, bool SP2 = false>
__device__ __forceinline__ void gemm_phase(PG8_LAS unsigned char* lds, int wid, const Gemm g, const Sched& S, const Epi& E) {
    const int lane = lane_id(), tid = wid * 64 + lane, wr = wid >> 2, wc = wid & 3, fr = lane & 15, fq = lane >> 4;
    const int K = g.K, nt = K / BK;
    unsigned voffA[2], voffB[2];
#pragma unroll
    for (int i = 0; i < 2; ++i) { int R, C; stage_rc(tid * 16 + i * 8192, R, C); const int Rb = Epi::PERM ? ((R & ~31) + perm32(R & 31)) : R;
        voffA[i] = (unsigned)(R * K + C) * 2u; voffB[i] = (unsigned)(Rb * K + C) * 2u; }
    const size_t kstep = (size_t)(BK * 2);
    const size_t hstep = (size_t)HALF * K * 2;
    const size_t tstep = 2 * hstep;
    const unsigned ldsw = (unsigned)wid * 1024u;
    const int aoff = lds_byte(wr * 64 + fr, fq * 8), boff = lds_byte(wc * 32 + fr, fq * 8);
#define PG8_SA(b, h) (((b) * 2 + (h)) * HTB)
#define PG8_SB(b, h) ((4 + (b) * 2 + (h)) * HTB)
#define PG8_STAGE(bufoff, gbase, voff) do { _Pragma("unroll") for (int _i = 0; _i < 2; ++_i) \
        __builtin_amdgcn_global_load_lds((const unsigned*)((const char*)(gbase) + (voff)[_i]), (PG8_LAS unsigned*)(lds + (bufoff) + ldsw + _i * 8192), 16, 0, 0); } while (0)
#define PG8_LDA(dst, b, h) do { _Pragma("unroll") for (int m = 0; m < 4; ++m) _Pragma("unroll") for (int k = 0; k < 2; ++k) dst[m][k] = *(const PG8_LAS bf16x8*)(lds + PG8_SA(b, h) + aoff + m * 2048 + k * 1024); } while (0)
#define PG8_LDB(dst, b, h) do { _Pragma("unroll") for (int n = 0; n < 2; ++n) _Pragma("unroll") for (int k = 0; k < 2; ++k) dst[n][k] = *(const PG8_LAS bf16x8*)(lds + PG8_SB(b, h) + boff + n * 2048 + k * 1024); } while (0)
#define PG8_MMA(ai, bj, At, Bt) do { __builtin_amdgcn_s_setprio(1); _Pragma("unroll") for (int m = 0; m < 4; ++m) _Pragma("unroll") for (int n = 0; n < 2; ++n) _Pragma("unroll") for (int k = 0; k < 2; ++k) \
        acc[ai][bj][m][n] = __builtin_amdgcn_mfma_f32_16x16x32_bf16(Bt[n][k], At[m][k], acc[ai][bj][m][n], 0, 0, 0); __builtin_amdgcn_s_setprio(0); } while (0)
#define PG8_WAIT_V(n) asm volatile("s_waitcnt vmcnt(" #n ")" ::: "memory")
#define PG8_WAIT_L(n) asm volatile("s_waitcnt lgkmcnt(" #n ")" ::: "memory")
#define PG8_BAR __builtin_amdgcn_s_barrier()
#define PG8_SCHED __builtin_amdgcn_sched_barrier(0)
    Unit cur, nxt; int ui = 0;
    if (!S.next(0, cur)) return;
    f32x4 acc[2][2][4][2];
#pragma unroll
    for (int a = 0; a < 2; ++a)
#pragma unroll
        for (int b = 0; b < 2; ++b)
#pragma unroll
            for (int m = 0; m < 4; ++m)
#pragma unroll
                for (int n = 0; n < 2; ++n) acc[a][b][m][n] = (f32x4){0.f, 0.f, 0.f, 0.f};
    bf16x8 At[4][2], B0[2][2], B1[2][2];
    const char* cA = (const char*)g.A + (size_t)cur.pm * tstep; const char* cB = (const char*)g.Bt + (size_t)cur.pn * tstep;
    S.a_ready(cur);
    if constexpr (SP2) {
        PG8_STAGE(PG8_SB(0, 0), cB, voffB); PG8_STAGE(PG8_SB(0, 1), cB + hstep, voffB); PG8_STAGE(PG8_SA(0, 0), cA, voffA); PG8_STAGE(PG8_SA(0, 1), cA + hstep, voffA);
        if (wr == 1) PG8_BAR;
        PG8_WAIT_V(2); PG8_BAR;
        PG8_STAGE(PG8_SB(1, 0), cB + kstep, voffB); PG8_STAGE(PG8_SA(1, 0), cA + kstep, voffA); PG8_STAGE(PG8_SB(1, 1), cB + hstep + kstep, voffB);
        PG8_WAIT_V(6); PG8_BAR;
    } else {
        PG8_STAGE(PG8_SB(0, 0), cB, voffB); PG8_STAGE(PG8_SA(0, 0), cA, voffA); PG8_STAGE(PG8_SB(0, 1), cB + hstep, voffB); PG8_STAGE(PG8_SA(0, 1), cA + hstep, voffA);
        if (wr == 1) PG8_BAR;
        PG8_WAIT_V(4); PG8_BAR;
        PG8_STAGE(PG8_SB(1, 0), cB + kstep, voffB); PG8_STAGE(PG8_SA(1, 0), cA + kstep, voffA); PG8_STAGE(PG8_SB(1, 1), cB + hstep + kstep, voffB);
        PG8_WAIT_V(6); PG8_BAR;
    }
    for (;;) {
        const bool has_next = S.next(ui + 1, nxt);
        const char* nA = has_next ? (const char*)g.A + (size_t)nxt.pm * tstep : cA; const char* nB = has_next ? (const char*)g.Bt + (size_t)nxt.pn * tstep : cB;
        for (int t = 0; t < nt; t += 2) {
            const bool last = (t == nt - 2);
            const char* a1 = cA + (size_t)(t + 1) * kstep;
            const char* a2 = last ? nA : cA + (size_t)(t + 2) * kstep; const char* b2 = last ? nB : cB + (size_t)(t + 2) * kstep;
            const char* a3 = a2 + kstep; const char* b3 = b2 + kstep;
            if (last && has_next) S.a_ready(nxt);
            if constexpr (SP2) {
            PG8_LDB(B0, 0, 0); PG8_LDB(B1, 0, 1); PG8_SCHED; PG8_LDA(At, 0, 0); PG8_STAGE(PG8_SA(1, 1), a1 + hstep, voffA);
            PG8_WAIT_V(8); PG8_WAIT_L(0); PG8_BAR; PG8_MMA(0, 0, At, B0); PG8_MMA(0, 1, At, B1); PG8_BAR; PG8_SCHED;
            PG8_LDA(At, 0, 1); PG8_STAGE(PG8_SB(0, 0), b2, voffB); PG8_STAGE(PG8_SB(0, 1), b2 + hstep, voffB); PG8_STAGE(PG8_SA(0, 0), a2, voffA);
            PG8_WAIT_V(8); PG8_WAIT_L(0); PG8_BAR; PG8_MMA(1, 0, At, B0); PG8_MMA(1, 1, At, B1); PG8_BAR; PG8_SCHED;
            PG8_LDB(B0, 1, 0); PG8_LDB(B1, 1, 1); PG8_SCHED; PG8_LDA(At, 1, 0); PG8_STAGE(PG8_SA(0, 1), a2 + hstep, voffA);
            PG8_WAIT_V(8); PG8_WAIT_L(0); PG8_BAR; PG8_MMA(0, 0, At, B0); PG8_MMA(0, 1, At, B1); PG8_BAR; PG8_SCHED;
            PG8_LDA(At, 1, 1); PG8_STAGE(PG8_SB(1, 0), b3, voffB); PG8_STAGE(PG8_SB(1, 1), b3 + hstep, voffB); PG8_STAGE(PG8_SA(1, 0), a3, voffA);
            PG8_WAIT_V(8); PG8_WAIT_L(0); PG8_BAR; PG8_MMA(1, 0, At, B0); PG8_MMA(1, 1, At, B1); PG8_BAR; PG8_SCHED;
            } else {
            PG8_LDB(B0, 0, 0); PG8_SCHED; PG8_LDA(At, 0, 0); PG8_STAGE(PG8_SA(1, 1), a1 + hstep, voffA);
            PG8_WAIT_L(8); PG8_BAR; PG8_WAIT_L(0); PG8_MMA(0, 0, At, B0); PG8_BAR; PG8_SCHED;
            PG8_LDB(B1, 0, 1); PG8_STAGE(PG8_SB(0, 0), b2, voffB);
            PG8_BAR; PG8_WAIT_L(0); PG8_MMA(0, 1, At, B1); PG8_BAR;
            PG8_LDA(At, 0, 1); PG8_STAGE(PG8_SA(0, 0), a2, voffA);
            PG8_BAR; PG8_WAIT_L(0); PG8_MMA(1, 0, At, B0); PG8_BAR; PG8_SCHED;
            PG8_STAGE(PG8_SB(0, 1), b2 + hstep, voffB);
            PG8_WAIT_V(6); PG8_BAR; PG8_MMA(1, 1, At, B1); PG8_BAR;
            PG8_LDB(B0, 1, 0); PG8_SCHED; PG8_LDA(At, 1, 0); PG8_STAGE(PG8_SA(0, 1), a2 + hstep, voffA);
            PG8_WAIT_L(8); PG8_BAR; PG8_WAIT_L(0); PG8_MMA(0, 0, At, B0); PG8_BAR; PG8_SCHED;
            PG8_LDB(B1, 1, 1); PG8_STAGE(PG8_SB(1, 0), b3, voffB);
            PG8_BAR; PG8_WAIT_L(0); PG8_MMA(0, 1, At, B1); PG8_BAR;
            PG8_LDA(At, 1, 1); PG8_STAGE(PG8_SA(1, 0), a3, voffA);
            PG8_BAR; PG8_WAIT_L(0); PG8_MMA(1, 0, At, B0); PG8_BAR; PG8_SCHED;
            PG8_STAGE(PG8_SB(1, 1), b3 + hstep, voffB);
            PG8_WAIT_V(6); PG8_BAR; PG8_MMA(1, 1, At, B1); PG8_BAR;
            }
        }
        if constexpr (ALIGN_EPI) { if (wr == 0) PG8_BAR; }
        if constexpr (!Epi::AFTER_DRAIN) { E(acc, cur, wr, wc, fr, fq); S.done(cur); }
        if (!has_next) break;
#pragma unroll
        for (int a = 0; a < 2; ++a)
#pragma unroll
            for (int b = 0; b < 2; ++b)
#pragma unroll
                for (int m = 0; m < 4; ++m)
#pragma unroll
                    for (int n = 0; n < 2; ++n) acc[a][b][m][n] = (f32x4){0.f, 0.f, 0.f, 0.f};
        cur = nxt; cA = nA; cB = nB; ++ui;
        if constexpr (ALIGN_EPI) { if (wr == 1) PG8_BAR; }
    }
    PG8_WAIT_V(0);
    if constexpr (!ALIGN_EPI) { if (wr == 0) PG8_BAR; }
    PG8_BAR;
#undef PG8_SA
#undef PG8_SB
#undef PG8_STAGE
#undef PG8_LDA
#undef PG8_LDB
#undef PG8_MMA
#undef PG8_WAIT_V
#undef PG8_WAIT_L
#undef PG8_BAR
#undef PG8_SCHED
}
}

constexpr int NWAVES = 8;
constexpr int NB = 4, SEQ = 4096, D = 1024, T = NB * SEQ;
constexpr int DI = 2048, NH = 32, HP = 64, NS = 128, CONVD = 3072, CHUNK = 128, NCHUNK = SEQ / CHUNK;
constexpr int AH = 16, AHD = 64, QW = 3072;
constexpr int FH = 2816;
constexpr int N_PHASES = 18;
constexpr float EPS = 1e-6f;

constexpr size_t MiB = 1u << 20;
constexpr size_t WS_CTL = 0, CTL_ZERO_BYTES = 1 * MiB;
constexpr size_t WS_MOD = 1 * MiB;
constexpr size_t WS_DT = 2 * MiB;
constexpr size_t WS_LSE = 4 * MiB;
constexpr size_t WS_PSSQ = 7 * MiB;
constexpr size_t WS_WDT = 9 * MiB;
constexpr size_t WS_WZX = 10 * MiB;
constexpr size_t WS_WQKV = 20 * MiB;
constexpr size_t WS_H = 30 * MiB;
constexpr size_t WS_BIG = 62 * MiB;
constexpr size_t WS_YA = 158 * MiB;
constexpr size_t WS_WOUT = 10 * MiB;
constexpr size_t WS_WGU0 = 16 * MiB;
constexpr size_t WS_WD0 = 27 * MiB;
constexpr size_t WS_WC1 = 33 * MiB;
constexpr size_t WS_WC2 = 37 * MiB;
constexpr size_t WS_WGU1 = 39 * MiB;
constexpr size_t WS_WD1 = 50 * MiB;
constexpr size_t WS_H1 = 62 * MiB;
constexpr size_t WS_HID = 94 * MiB;
constexpr size_t WS_U = 182 * MiB;
constexpr size_t WS_V2 = 214 * MiB;
constexpr size_t WS_END = 256 * MiB;
constexpr int CW_BAR = 4096;

constexpr int LDS_BYTES = 163840;
constexpr int MISC_OFF = LDS_BYTES - 256;

#define GAS __attribute__((address_space(1)))
#define LAS __attribute__((address_space(3)))
typedef unsigned short bf16;
typedef unsigned v4u __attribute__((ext_vector_type(4)));
typedef unsigned v2u __attribute__((ext_vector_type(2)));
typedef float f32x4 __attribute__((ext_vector_type(4)));
typedef float f32x16 __attribute__((ext_vector_type(16)));
typedef short bf16x8 __attribute__((ext_vector_type(8)));
typedef short s16x4 __attribute__((ext_vector_type(4)));
typedef GAS unsigned gu32;
#define RLX_AGENT __ATOMIC_RELAXED, __HIP_MEMORY_SCOPE_AGENT
#define LDS_WAIT() asm volatile("s_waitcnt lgkmcnt(0)" ::: "memory")
#define VM_WAIT() asm volatile("s_waitcnt vmcnt(0)" ::: "memory")
__device__ __forceinline__ unsigned f2bf(float f) { unsigned u = __builtin_bit_cast(unsigned, f); return (u + 0x7fffu + ((u >> 16) & 1u)) >> 16; }
__device__ __forceinline__ unsigned pk2(float lo, float hi) { return f2bf(lo) | (f2bf(hi) << 16); }
__device__ __forceinline__ float bflo(unsigned w) { return __builtin_bit_cast(float, w << 16); }
__device__ __forceinline__ float bfhi(unsigned w) { return __builtin_bit_cast(float, w & 0xffff0000u); }
__device__ __forceinline__ float fexp(float v) { return __builtin_amdgcn_exp2f(1.4426950408889634f * v); }
__device__ __forceinline__ float siluf(float v) { return v * __builtin_amdgcn_rcpf(1.0f + fexp(-v)); }

__device__ const unsigned char T5_BUCKET[3][132] = {
{0,1,2,3,4,5,6,7,8,9,10,11,12,13,14,15,16,16,16,16,16,16,17,17,17,17,17,17,17,17,18,18,18,18,18,18,18,18,18,18,19,19,19,19,19,19,19,19,19,19,19,19,19,19,20,20,20,20,20,20,20,20,20,20,20,20,20,20,20,20,20,20,20,21,21,21,21,21,21,21,21,21,21,21,21,21,21,21,21,21,21,21,21,21,21,21,21,21,21,22,22,22,22,22,22,22,22,22,22,22,22,22,22,22,22,22,22,22,22,22,22,22,22,22,22,22,22,22,22},
{0,4,8,12,16,16,17,17,18,18,19,19,19,19,20,20,20,20,20,21,21,21,21,21,21,22,22,22,22,22,22,22,22,22,23,23,23,23,23,23,23,23,23,23,23,23,24,24,24,24,24,24,24,24,24,24,24,24,24,24,24,24,25,25,25,25,25,25,25,25,25,25,25,25,25,25,25,25,25,25,25,25,25,26,26,26,26,26,26,26,26,26,26,26,26,26,26,26,26,26,26,26,26,26,26,26,26,26,26,26,26,26,26,27,27,27,27,27,27,27,27,27,27,27,27,27,27,27,27},
{0,16,18,19,20,21,21,22,22,23,23,23,24,24,24,24,25,25,25,25,25,26,26,26,26,26,26,26,26,27,27,27,27,27,27,27,27,27,27,28,28,28,28,28,28,28,28,28,28,28,28,28,29,29,29,29,29,29,29,29,29,29,29,29,29,29,29,29,29,29,30,30,30,30,30,30,30,30,30,30,30,30,30,30,30,30,30,30,30,30,30,30,30,30,30,31,31,31,31,31,31,31,31,31,31,31,31,31,31,31,31,31,31,31,31,31,31,31,31,31,31,31,31,31,31,31,31,31,31}};

#define XB_TMO      128
#define XB_XCNT(j)  (256  + 64 * (j))
#define XB_XSUB(j)  (1280 + 64 * (j))
#define XB_XGEN(j)  (2304 + 64 * (j))
#define XB_TOP      3328
#define XB_TOPGEN   3392
#define XCD_BAR_WORDS 3456
#define XB_SPIN_CAP (1u << 18)
__device__ __forceinline__ unsigned xb_ld(unsigned* p)              { return __hip_atomic_load(p, __ATOMIC_RELAXED, __HIP_MEMORY_SCOPE_AGENT); }
__device__ __forceinline__ unsigned xb_add(unsigned* p, unsigned v) { return __hip_atomic_fetch_add(p, v, __ATOMIC_RELAXED, __HIP_MEMORY_SCOPE_AGENT); }
__device__ __forceinline__ unsigned xb_xcc_id() { return (unsigned)__builtin_amdgcn_s_getreg((3 << 11) | 20) & 0xFu; }
#define XB_SPIN(cond, bar) do { unsigned _sp = 0; while (cond) { __builtin_amdgcn_s_sleep(1); \
    if ((++_sp & 255u) == 0u) { if (xb_ld(&(bar)[XB_TMO])) break; if (_sp > XB_SPIN_CAP) { atomicAdd(&(bar)[XB_TMO], 1u); break; } } } } while (0)
struct XcdBarrier { unsigned* bar; unsigned x; volatile LAS unsigned* st; };
__device__ __forceinline__ XcdBarrier xcd_barrier_post(unsigned* bar, volatile LAS unsigned* st, bool leader) {
    XcdBarrier b; b.bar = bar; b.x = xb_xcc_id(); b.st = st;
    if (leader) (void)xb_add(&bar[XB_XCNT(b.x)], 1u);
    return b;
}
__device__ __forceinline__ void xcd_barrier_complete(unsigned* bar, unsigned x, unsigned& nloc, unsigned& nx) {
    const unsigned G = gridDim.x * gridDim.y * gridDim.z;
    unsigned sum, cnt, mine, sp = 0u;
    for (;;) {
        sum = 0u; cnt = 0u; mine = 0u;
#pragma unroll
        for (unsigned j = 0; j < 16; ++j) { const unsigned c = xb_ld(&bar[XB_XCNT(j)]); sum += c; cnt += (c > 0u) ? 1u : 0u; mine = (j == x) ? c : mine; }
        if (sum == G) break;
        __builtin_amdgcn_s_sleep(1);
        if ((++sp & 255u) == 0u) { if (xb_ld(&bar[XB_TMO])) break; if (sp > XB_SPIN_CAP) { atomicAdd(&bar[XB_TMO], 1u); break; } }
    }
    nloc = mine > 0u ? mine : 1u; nx = cnt > 0u ? cnt : 1u;
}
__device__ __forceinline__ void xcd_barrier(const XcdBarrier& b, int wave) {
    asm volatile("s_waitcnt vmcnt(0)" ::: "memory");
    __syncthreads();
    if (wave == 0 && lane_id() == 0) {
        unsigned* bar = b.bar;
        __builtin_amdgcn_s_waitcnt(0);
        unsigned nloc = b.st[0], nx = b.st[1];
        if (nloc == 0u) { xcd_barrier_complete(bar, b.x, nloc, nx); b.st[0] = nloc; b.st[1] = nx; }
        const unsigned old = xb_add(&bar[XB_XSUB(b.x)], 1u);
        const unsigned gen = old / nloc;
        if (old + 1u == (gen + 1u) * nloc) {
            __builtin_amdgcn_fence(__ATOMIC_RELEASE, "agent");
            asm volatile("s_waitcnt vmcnt(0)" ::: "memory");
            const unsigned og = xb_add(&bar[XB_TOP], 1u);
            const unsigned tg = og / nx;
            if (og + 1u == (tg + 1u) * nx) xb_add(&bar[XB_TOPGEN], 1u);
            else XB_SPIN(xb_ld(&bar[XB_TOPGEN]) == tg, bar);
            __builtin_amdgcn_fence(__ATOMIC_ACQUIRE, "agent");
            xb_add(&bar[XB_XGEN(b.x)], 1u);
            asm volatile("s_waitcnt vmcnt(0)" ::: "memory");
        } else {
            XB_SPIN(xb_ld(&bar[XB_XGEN(b.x)]) == gen, bar);
            __builtin_amdgcn_fence(__ATOMIC_ACQUIRE, "agent");
            asm volatile("s_waitcnt vmcnt(0)" ::: "memory");
        }
    }
    __syncthreads();
}

struct Frame {
    LAS unsigned char* lds;
    int wave;
    int vcu, G;
    const float* const* in;
    unsigned char* ws; float* out;
};
__device__ __forceinline__ float wave_sum(float v) {
#pragma unroll
    for (int o = 1; o < 64; o <<= 1) v += __shfl_xor(v, o);
    return v;
}
__device__ __forceinline__ int rowidx(int r, int hh) { return (r & 3) + 8 * (r >> 2) + 4 * hh; }

__device__ __forceinline__ void transpose_block(const float* Wsrc, int N, bf16* dst, int Kd, LAS float* scr, int lane) {
#pragma unroll 8
    for (int i = 0; i < 32; ++i) { const int kk = 2 * i + (lane >> 5); scr[kk * 33 + (lane & 31)] = Wsrc[(size_t)kk * N + (lane & 31)]; }
    LDS_WAIT(); asm volatile("" ::: "memory");
    const int c = lane & 7;
#pragma unroll
    for (int j = 0; j < 4; ++j) { const int n = (lane >> 3) + 8 * j; const LAS float* s = scr + (8 * c) * 33 + n;
        v4u o; o.x = pk2(s[0 * 33], s[1 * 33]); o.y = pk2(s[2 * 33], s[3 * 33]); o.z = pk2(s[4 * 33], s[5 * 33]); o.w = pk2(s[6 * 33], s[7 * 33]);
        *(GAS v4u*)(dst + (size_t)n * Kd + 8 * c) = o; }
    LDS_WAIT(); asm volatile("" ::: "memory");
}
__device__ __forceinline__ void cvt_win_item(const float* w_in, unsigned char* ws, int kb, int nb, LAS float* scr, int lane) {
    const int n0 = 32 * nb; bf16* dst;
    if (n0 < 5120) dst = (bf16*)(ws + WS_WZX) + (size_t)n0 * 1024;
    else if (n0 == 5120) dst = (bf16*)(ws + WS_WDT);
    else dst = (bf16*)(ws + WS_WQKV) + (size_t)(n0 - 5152) * 1024;
    transpose_block(w_in + (size_t)(64 * kb) * 10272 + n0, 10272, dst + 64 * kb, 1024, scr, lane);
}
__device__ __forceinline__ void cvt_plain_item(const float* W, int K, int N, bf16* WT, int item, LAS float* scr, int lane) {
    const int nblk = N / 32, kb = item / nblk, nb = item % nblk;
    transpose_block(W + (size_t)(64 * kb) * N + 32 * nb, N, WT + (size_t)(32 * nb) * K + 64 * kb, K, scr, lane);
}
__device__ __forceinline__ void cvt_pair_item(const float* W, int K, int Nsrc, int coff, int Nhalf, int sel, bf16* WT, int item, LAS float* scr, int lane) {
    const int nblk = Nhalf / 32, kb = item / nblk, nb = item % nblk, n0 = 32 * nb;
    const int drow = (n0 >> 7) * 256 + sel * 128 + (n0 & 127);
    transpose_block(W + (size_t)(64 * kb) * Nsrc + coff + n0, Nsrc, WT + (size_t)drow * K + 64 * kb, K, scr, lane);
}

__device__ __forceinline__ void adaln_row(const float* xrow, const float* g, const float* sc, const float* sh, int lane, unsigned (&pk)[4][2]) {
    const GAS f32x4* xr = (const GAS f32x4*)xrow + lane;
    f32x4 v[4]; float s = 0.f;
#pragma unroll
    for (int j = 0; j < 4; ++j) { v[j] = xr[64 * j]; s += (v[j].x * v[j].x + v[j].y * v[j].y) + (v[j].z * v[j].z + v[j].w * v[j].w); }
    const float rstd = 1.0f / sqrtf(wave_sum(s) * (1.0f / D) + EPS);
#pragma unroll
    for (int j = 0; j < 4; ++j) {
        const f32x4 gv = ((const GAS f32x4*)g)[lane + 64 * j], scv = ((const GAS f32x4*)sc)[lane + 64 * j], shv = ((const GAS f32x4*)sh)[lane + 64 * j];
        const f32x4 hv = (v[j] * rstd) * gv * (scv + 1.0f) + shv;
        pk[j][0] = pk2(hv.x, hv.y); pk[j][1] = pk2(hv.z, hv.w);
    }
}
__device__ __forceinline__ void norm_phase(Frame& F, const float* X, const float* g, const float* modsh, const float* modsc, bf16* out) {
    const int gw = F.vcu * NWAVES + F.wave, NGW = F.G * NWAVES, lane = lane_id();
    for (int m = gw; m < T; m += NGW) {
        const int b = m >> 12; unsigned pk[4][2];
        adaln_row(X + (size_t)m * D, g, modsc + (size_t)b * 6144, modsh + (size_t)b * 6144, lane, pk);
        GAS v2u* o8 = (GAS v2u*)(out + (size_t)m * D) + lane;
#pragma unroll
        for (int j = 0; j < 4; ++j) o8[64 * j] = (v2u){pk[j][0], pk[j][1]};
    }
}

__device__ __forceinline__ void p0_phase(Frame& F, const float* c, const float* ada_w, const float* ada_b, const float* w_in) {
    LAS float* cs = (LAS float*)(F.lds);
    LAS float* red = (LAS float*)(F.lds + 16384);
    float* MOD = (float*)(F.ws + WS_MOD);
    const int lane = lane_id(), tid = F.wave * 64 + lane;
    if (F.vcu < 192) {
        for (int i = tid; i < 4096; i += NWAVES * 64) cs[i] = siluf(c[i]);
        __syncthreads();
        for (int cb = F.vcu; cb < 192; cb += F.G) {
            const int gc = cb * 64 + lane, li = gc / 6144, n = gc % 6144;
            const float* w = ada_w + (size_t)li * 1024 * 6144 + n;
            float a0 = 0.f, a1 = 0.f, a2 = 0.f, a3 = 0.f;
            const int k0 = F.wave * 128;
#pragma unroll 8
            for (int k = k0; k < k0 + 128; ++k) { const float wv = w[(size_t)k * 6144]; a0 += cs[k] * wv; a1 += cs[1024 + k] * wv; a2 += cs[2048 + k] * wv; a3 += cs[3072 + k] * wv; }
            red[(F.wave * 4 + 0) * 64 + lane] = a0; red[(F.wave * 4 + 1) * 64 + lane] = a1; red[(F.wave * 4 + 2) * 64 + lane] = a2; red[(F.wave * 4 + 3) * 64 + lane] = a3;
            __syncthreads();
            if (tid < 256) { const int b = tid >> 6, l = tid & 63; float s = 0.f;
#pragma unroll
                for (int w8 = 0; w8 < 8; ++w8) s += red[(w8 * 4 + b) * 64 + l];
                const int gc2 = cb * 64 + l, li2 = gc2 / 6144, n2 = gc2 % 6144;
                MOD[(size_t)(li2 * 4 + b) * 6144 + n2] = s + ada_b[(size_t)li2 * 6144 + n2]; }
            __syncthreads();
        }
    }
    LAS float* scr = (LAS float*)(F.lds + 32768 + F.wave * 8704);
    const int gw = F.vcu * NWAVES + F.wave, NGW = F.G * NWAVES;
    for (int it = gw; it < 161 * 16; it += NGW) cvt_win_item(w_in, F.ws, it / 161, it % 161, scr, lane);
}

__device__ __forceinline__ void p1_phase(Frame& F, const float* x, const float* g, const float* dt_bias) {
    const float* MOD = (const float*)(F.ws + WS_MOD);
    bf16* H = (bf16*)(F.ws + WS_H); float* DT = (float*)(F.ws + WS_DT); const bf16* WDT = (const bf16*)(F.ws + WS_WDT);
    constexpr int HRS = 2064;
    const int lane = lane_id(), tid = F.wave * 64 + lane;
    for (int rg = F.vcu; rg < T / 64; rg += F.G) {
#pragma unroll 1
        for (int i = 0; i < 8; ++i) {
            const int rl = F.wave * 8 + i, m = rg * 64 + rl, b = m >> 12; unsigned pk[4][2];
            adaln_row(x + (size_t)m * D, g, MOD + (size_t)b * 6144 + 1024, MOD + (size_t)b * 6144 + 0, lane, pk);
            GAS v2u* o8 = (GAS v2u*)(H + (size_t)m * D) + lane;
#pragma unroll
            for (int j = 0; j < 4; ++j) { o8[64 * j] = (v2u){pk[j][0], pk[j][1]}; *(LAS v2u*)(F.lds + rl * HRS + (4 * lane + 256 * j) * 2) = (v2u){pk[j][0], pk[j][1]}; }
        }
        __syncthreads();
        const int mt = F.wave & 1, kq = F.wave >> 1, r32 = lane & 31, hh = lane >> 5;
        f32x16 acc = {};
        const LAS unsigned char* ap = F.lds + (32 * mt + r32) * HRS + (256 * kq + 8 * hh) * 2;
        const bf16* bp = WDT + (size_t)r32 * 1024 + 256 * kq + 8 * hh;
#pragma unroll 4
        for (int s = 0; s < 16; ++s) { const bf16x8 a = *(const LAS bf16x8*)(ap + 32 * s); const bf16x8 bb = *(const GAS bf16x8*)(bp + 16 * s); acc = __builtin_amdgcn_mfma_f32_32x32x16_bf16(a, bb, acc, 0, 0, 0); }
        __syncthreads();
        LAS float* red = (LAS float*)F.lds;
#pragma unroll
        for (int r = 0; r < 16; ++r) red[((kq * 2 + mt) * 32 + rowidx(r, hh)) * 32 + r32] = acc[r];
        __syncthreads();
#pragma unroll
        for (int i = 0; i < 4; ++i) { const int o = tid + 512 * i, row = o >> 5, col = o & 31; float s = 0.f;
#pragma unroll
            for (int q = 0; q < 4; ++q) s += red[((q * 2 + (row >> 5)) * 32 + (row & 31)) * 32 + col];
            const float v = s + dt_bias[col];
            const float sp = fmaxf(v, 0.f) + log1pf(__expf(-fabsf(v)));
            DT[(size_t)(rg * 64 + row) * 32 + col] = sp; }
        __syncthreads();
    }
}

__device__ __forceinline__ f32x16 mma_lds(f32x16 acc, const LAS unsigned char* A, const LAS unsigned char* B, int ksteps, int lane) {
    const int r = lane & 31, hh = lane >> 5;
    const LAS unsigned char* pa = A + r * 272 + hh * 16; const LAS unsigned char* pb = B + r * 272 + hh * 16;
    for (int s = 0; s < ksteps; ++s) { const bf16x8 a = *(const LAS bf16x8*)(pa + 32 * s); const bf16x8 bb = *(const LAS bf16x8*)(pb + 32 * s); acc = __builtin_amdgcn_mfma_f32_32x32x16_bf16(a, bb, acc, 0, 0, 0); }
    return acc;
}
template <int NTOK> __device__ __forceinline__ void conv8(const bf16* XBC, int b, int tfirst, int col, const float* conv_w, const float* conv_b, float (&val)[NTOK][8]) {
    f32x4 w[4][2];
#pragma unroll
    for (int k = 0; k < 4; ++k) { w[k][0] = *(const GAS f32x4*)(conv_w + (size_t)k * CONVD + col); w[k][1] = *(const GAS f32x4*)(conv_w + (size_t)k * CONVD + col + 4); }
    const f32x4 b0 = *(const GAS f32x4*)(conv_b + col), b1 = *(const GAS f32x4*)(conv_b + col + 4);
    v4u raw[NTOK + 3];
#pragma unroll
    for (int i = 0; i < NTOK + 3; ++i) { const int t = tfirst - 3 + i;
        raw[i] = (t >= 0) ? *(const GAS v4u*)(XBC + ((size_t)b * SEQ + t) * CONVD + col) : (v4u){0u, 0u, 0u, 0u}; }
#pragma unroll
    for (int o = 0; o < NTOK; ++o) {
        float a[8] = {b0.x, b0.y, b0.z, b0.w, b1.x, b1.y, b1.z, b1.w};
#pragma unroll
        for (int k = 0; k < 4; ++k) { const v4u rw = raw[o + k];
            a[0] += w[k][0].x * bflo(rw.x); a[1] += w[k][0].y * bfhi(rw.x); a[2] += w[k][0].z * bflo(rw.y); a[3] += w[k][0].w * bfhi(rw.y);
            a[4] += w[k][1].x * bflo(rw.z); a[5] += w[k][1].y * bfhi(rw.z); a[6] += w[k][1].z * bflo(rw.w); a[7] += w[k][1].w * bfhi(rw.w); }
#pragma unroll
        for (int j = 0; j < 8; ++j) val[o][j] = siluf(a[j]);
    }
}
constexpr int SO_CS = 0, SO_BS = 34816, SO_BDT = 69632, SO_XT = 104448, SO_HT = 121856, SO_XS = 139264, SO_TAB = 157696;
__device__ __forceinline__ void ssd_chain(Frame& F, int b, int h, const float* conv_w, const float* conv_b, const float* a_log, const float* d_skip) {
    const int g = h >> 3, lane = lane_id(), wave = F.wave, tid = wave * 64 + lane, r32 = lane & 31, hh = lane >> 5;
    LAS unsigned char* L = F.lds;
    LAS float* acs = (LAS float*)(L + SO_TAB); LAS float* dtv = acs + 128; LAS float* eacs = acs + 256; LAS float* dend = acs + 384;
    const bf16* XBC = (const bf16*)(F.ws + WS_BIG); const bf16* Z = (const bf16*)F.out; const float* DT = (const float*)(F.ws + WS_DT);
    bf16* YA = (bf16*)(F.ws + WS_YA); float* PSSQ = (float*)(F.ws + WS_PSSQ);
    const float A_h = -__expf(a_log[h]), D_h = d_skip[h];
    f32x16 Hst = {};
#pragma unroll 1
    for (int c = 0; c < NCHUNK; ++c) {
        const int t0 = c * CHUNK; const size_t rowbase = (size_t)b * SEQ + t0;
        if (wave == 0) {
            const float d0 = DT[(rowbase + 2 * lane) * 32 + h], d1 = DT[(rowbase + 2 * lane + 1) * 32 + h];
            const float a0 = d0 * A_h, a1 = d1 * A_h, s = a0 + a1;
            float incl = s;
#pragma unroll
            for (int o = 1; o < 64; o <<= 1) { const float t = __shfl_up(incl, o); if (lane >= o) incl += t; }
            const float c0 = incl - s + a0, c1 = incl, tot = __shfl(incl, 63);
            acs[2 * lane] = c0; acs[2 * lane + 1] = c1; dtv[2 * lane] = d0; dtv[2 * lane + 1] = d1;
            eacs[2 * lane] = __expf(c0); eacs[2 * lane + 1] = __expf(c1); dend[2 * lane] = __expf(tot - c0); dend[2 * lane + 1] = __expf(tot - c1);
        }
        __syncthreads();
        {   const int chunk = tid & 15, run = tid >> 4, s0 = 4 * run; float val[4][8];
            conv8<4>(XBC, b, t0 + s0, 2560 + g * 128 + 8 * chunk, conv_w, conv_b, val);
#pragma unroll
            for (int o = 0; o < 4; ++o) *(LAS v4u*)(L + SO_CS + (s0 + o) * 272 + chunk * 16) = (v4u){pk2(val[o][0], val[o][1]), pk2(val[o][2], val[o][3]), pk2(val[o][4], val[o][5]), pk2(val[o][6], val[o][7])};
            conv8<4>(XBC, b, t0 + s0, 2048 + g * 128 + 8 * chunk, conv_w, conv_b, val);
#pragma unroll
            for (int o = 0; o < 4; ++o) *(LAS v4u*)(L + SO_BS + (s0 + o) * 272 + chunk * 16) = (v4u){pk2(val[o][0], val[o][1]), pk2(val[o][2], val[o][3]), pk2(val[o][4], val[o][5]), pk2(val[o][6], val[o][7])};
            const f32x4 de = *(const LAS f32x4*)(dend + s0);
#pragma unroll
            for (int j = 0; j < 8; ++j) *(LAS v2u*)(L + SO_BDT + (8 * chunk + j) * 272 + s0 * 2) = (v2u){pk2(val[0][j] * de.x, val[1][j] * de.y), pk2(val[2][j] * de.z, val[3][j] * de.w)};
        }
        {   const int chunk = tid & 7, run = tid >> 3, s0 = 2 * run; float val[2][8];
            conv8<2>(XBC, b, t0 + s0, h * 64 + 8 * chunk, conv_w, conv_b, val);
#pragma unroll
            for (int o = 0; o < 2; ++o) *(LAS v4u*)(L + SO_XS + (s0 + o) * 144 + chunk * 16) = (v4u){pk2(val[o][0], val[o][1]), pk2(val[o][2], val[o][3]), pk2(val[o][4], val[o][5]), pk2(val[o][6], val[o][7])};
            const float d0 = dtv[s0], d1 = dtv[s0 + 1];
#pragma unroll
            for (int j = 0; j < 8; ++j) *(LAS unsigned*)(L + SO_XT + (8 * chunk + j) * 272 + s0 * 2) = pk2(val[0][j] * d0, val[1][j] * d1);
        }
        __syncthreads();
        const int st = wave >> 1, lt0 = 2 * (wave & 1);
        f32x16 cb0 = {}, cb1 = {};
        cb0 = mma_lds(cb0, L + SO_BS + 32 * st * 272, L + SO_CS + 32 * lt0 * 272, 8, lane);
        cb1 = mma_lds(cb1, L + SO_BS + 32 * st * 272, L + SO_CS + 32 * (lt0 + 1) * 272, 8, lane);
        __syncthreads();
#pragma unroll
        for (int i = 0; i < 2; ++i) { const int l_ = 32 * (lt0 + i) + r32; const float el = acs[l_];
#pragma unroll
            for (int q = 0; q < 4; ++q) { const int sb = 32 * st + 8 * q + 4 * hh; const f32x4 as4 = *(const LAS f32x4*)(acs + sb); float mv[4];
#pragma unroll
                for (int jj = 0; jj < 4; ++jj) { const float cv = (i == 0) ? cb0[4 * q + jj] : cb1[4 * q + jj]; mv[jj] = (l_ >= sb + jj) ? cv * __expf(fminf(el - as4[jj], 0.f)) : 0.f; }
                *(LAS v2u*)(L + SO_BS + l_ * 272 + sb * 2) = (v2u){pk2(mv[0], mv[1]), pk2(mv[2], mv[3])}; } }
        {
            const int nt = wave >> 1, pt = wave & 1, p_ = 32 * pt + r32;
#pragma unroll
            for (int q = 0; q < 4; ++q) { const int nb = 32 * nt + 8 * q + 4 * hh;
                *(LAS v2u*)(L + SO_HT + p_ * 272 + nb * 2) = (v2u){pk2(Hst[4 * q], Hst[4 * q + 1]), pk2(Hst[4 * q + 2], Hst[4 * q + 3])}; } }
        __syncthreads();
        const int lt = wave >> 1, pt = wave & 1;
        f32x16 y = {};
        y = mma_lds(y, L + SO_CS + 32 * lt * 272, L + SO_HT + 32 * pt * 272, 8, lane);
#pragma unroll
        for (int q = 0; q < 4; ++q) { const f32x4 e4 = *(const LAS f32x4*)(eacs + 32 * lt + 8 * q + 4 * hh);
            y[4 * q] *= e4.x; y[4 * q + 1] *= e4.y; y[4 * q + 2] *= e4.z; y[4 * q + 3] *= e4.w; }
        y = mma_lds(y, L + SO_BS + 32 * lt * 272, L + SO_XT + 32 * pt * 272, 2 * (lt + 1), lane);
        {   const float etot = eacs[127];
#pragma unroll
            for (int r = 0; r < 16; ++r) Hst[r] *= etot;
            Hst = mma_lds(Hst, L + SO_BDT + 32 * lt * 272, L + SO_XT + 32 * pt * 272, 8, lane); }
        __syncthreads();
#pragma unroll
        for (int r = 0; r < 16; ++r) *(LAS float*)(L + SO_CS + (32 * lt + rowidx(r, hh)) * 272 + (32 * pt + r32) * 4) = y[r];
        __syncthreads();
        {   const int l = tid >> 2, pc = tid & 3, p0 = 16 * pc; const size_t row = rowbase + l;
            const v4u zz0 = *(const GAS v4u*)(Z + row * DI + h * 64 + p0), zz1 = *(const GAS v4u*)(Z + row * DI + h * 64 + p0 + 8);
            const v4u xx0 = *(const LAS v4u*)(L + SO_XS + l * 144 + p0 * 2), xx1 = *(const LAS v4u*)(L + SO_XS + l * 144 + p0 * 2 + 16);
            float yv[16], xv[16], zv[16];
#pragma unroll
            for (int i = 0; i < 4; ++i) { const f32x4 t = *(const LAS f32x4*)(L + SO_CS + l * 272 + (p0 + 4 * i) * 4); yv[4 * i] = t.x; yv[4 * i + 1] = t.y; yv[4 * i + 2] = t.z; yv[4 * i + 3] = t.w; }
            const unsigned xw[8] = {xx0.x, xx0.y, xx0.z, xx0.w, xx1.x, xx1.y, xx1.z, xx1.w}, zw[8] = {zz0.x, zz0.y, zz0.z, zz0.w, zz1.x, zz1.y, zz1.z, zz1.w};
#pragma unroll
            for (int i = 0; i < 8; ++i) { xv[2 * i] = bflo(xw[i]); xv[2 * i + 1] = bfhi(xw[i]); zv[2 * i] = bflo(zw[i]); zv[2 * i + 1] = bfhi(zw[i]); }
            float gv[16], ss = 0.f;
#pragma unroll
            for (int i = 0; i < 16; ++i) { gv[i] = (yv[i] + D_h * xv[i]) * siluf(zv[i]); ss += gv[i] * gv[i]; }
            bf16* yo = YA + row * 3072 + h * 64 + p0;
            *(GAS v4u*)yo = (v4u){pk2(gv[0], gv[1]), pk2(gv[2], gv[3]), pk2(gv[4], gv[5]), pk2(gv[6], gv[7])};
            *(GAS v4u*)(yo + 8) = (v4u){pk2(gv[8], gv[9]), pk2(gv[10], gv[11]), pk2(gv[12], gv[13]), pk2(gv[14], gv[15])};
            ss += __shfl_xor(ss, 1); ss += __shfl_xor(ss, 2);
            if (pc == 0) PSSQ[row * 32 + h] = ss;
        }
        __syncthreads();
    }
}

__device__ __forceinline__ s16x4 vtr(const LAS unsigned char* p) { typedef short v4i16_t __attribute__((ext_vector_type(4))); return __builtin_bit_cast(s16x4, __builtin_amdgcn_ds_read_tr16_b64_v4i16((LAS v4i16_t*)p)); }
constexpr int AO_BIAS = 0, AO_VST = 2048, VST_BYTES = 4608;
__device__ __forceinline__ void attn_wave_tile(Frame& F, int b, int h, int gi, int res, int m0, bf16* Q, const bf16* Kt, const bf16* Vt, float* LSE) {
    const int lane = lane_id(), r32 = lane & 31, hh = lane >> 5;
    const int dsh = 2 * gi;
    const LAS float* biasv = (const LAS float*)(F.lds + AO_BIAS) + gi * 132;
    LAS unsigned char* vst = F.lds + AO_VST + F.wave * VST_BYTES;
    const size_t qrow = (size_t)b * SEQ + ((size_t)(m0 + r32) << dsh) + res;
    const bf16* qp = Q + qrow * QW + gi * 1024 + h * 64 + hh * 8;
    bf16x8 qf[4];
#pragma unroll
    for (int s = 0; s < 4; ++s) qf[s] = *(const GAS bf16x8*)(qp + 16 * s);
    f32x16 sc[5];
#pragma unroll
    for (int kb = 0; kb < 5; ++kb) {
        int kpos = m0 - 128 + 32 * kb + r32; kpos = kpos < 0 ? 0 : kpos;
        const bf16* kp = Kt + ((size_t)b * SEQ + ((size_t)kpos << dsh) + res) * D + h * 64 + hh * 8;
        f32x16 acc = {};
#pragma unroll
        for (int s = 0; s < 4; ++s) { const bf16x8 kf = *(const GAS bf16x8*)(kp + 16 * s); acc = __builtin_amdgcn_mfma_f32_32x32x16_bf16(kf, qf[s], acc, 0, 0, 0); }
        sc[kb] = acc;
    }
    float mx = -INFINITY;
#pragma unroll
    for (int kb = 0; kb < 5; ++kb)
#pragma unroll
        for (int r = 0; r < 16; ++r) { const int ki = rowidx(r, hh), kpos = m0 - 128 + 32 * kb + ki, delta = r32 + 128 - 32 * kb - ki;
            const bool valid = (delta >= 0) && (delta <= 128) && (kpos >= 0);
            const int dc = delta < 0 ? 0 : (delta > 128 ? 128 : delta);
            const float v = valid ? sc[kb][r] * 0.125f + biasv[dc] : -INFINITY;
            sc[kb][r] = v; mx = fmaxf(mx, v); }
    mx = fmaxf(mx, __shfl_xor(mx, 32));
    float lsum = 0.f;
#pragma unroll
    for (int kb = 0; kb < 5; ++kb)
#pragma unroll
        for (int r = 0; r < 16; ++r) { const float p = fexp(sc[kb][r] - mx); sc[kb][r] = p; lsum += p; }
    lsum += __shfl_xor(lsum, 32);
    f32x16 o0 = {}, o1 = {};
    const int g4 = lane >> 4, q_ = (lane & 15) >> 2, p_ = lane & 3;
    const LAS unsigned char* trb = vst + (4 * (g4 >> 1) + q_) * 144 + (16 * (g4 & 1) + 4 * p_) * 2;
#pragma unroll
    for (int kb = 0; kb < 5; ++kb) {
#pragma unroll
        for (int i = 0; i < 4; ++i) { const int cc = lane + 64 * i, key = cc >> 3, dc = cc & 7; int kpos = m0 - 128 + 32 * kb + key; kpos = kpos < 0 ? 0 : kpos;
            const v4u v = *(const GAS v4u*)(Vt + ((size_t)b * SEQ + ((size_t)kpos << dsh) + res) * D + h * 64 + 8 * dc);
            *(LAS v4u*)(vst + key * 144 + dc * 16) = v; }
        asm volatile("" ::: "memory");
#pragma unroll
        for (int s = 0; s < 2; ++s) {
            const f32x16& P = sc[kb];
            v4u pw = (v4u){pk2(P[8 * s], P[8 * s + 1]), pk2(P[8 * s + 2], P[8 * s + 3]), pk2(P[8 * s + 4], P[8 * s + 5]), pk2(P[8 * s + 6], P[8 * s + 7])};
            const bf16x8 pa = __builtin_bit_cast(bf16x8, pw);
#pragma unroll
            for (int db = 0; db < 2; ++db) {
                const s16x4 lo = vtr(trb + (16 * s) * 144 + db * 64), hi = vtr(trb + (16 * s + 8) * 144 + db * 64);
                const bf16x8 vb = (bf16x8){lo[0], lo[1], lo[2], lo[3], hi[0], hi[1], hi[2], hi[3]};
                if (db == 0) o0 = __builtin_amdgcn_mfma_f32_32x32x16_bf16(pa, vb, o0, 0, 0, 0); else o1 = __builtin_amdgcn_mfma_f32_32x32x16_bf16(pa, vb, o1, 0, 0, 0);
            }
        }
    }
    const float linv = 1.0f / lsum;
#pragma unroll
    for (int r = 0; r < 16; ++r) { const int q = rowidx(r, hh); const float li = __shfl(linv, q);
        *(LAS bf16*)(vst + q * 144 + r32 * 2) = (bf16)f2bf(o0[r] * li); *(LAS bf16*)(vst + q * 144 + (32 + r32) * 2) = (bf16)f2bf(o1[r] * li); }
    asm volatile("s_waitcnt lgkmcnt(0)" ::: "memory");
#pragma unroll
    for (int i = 0; i < 4; ++i) { const int cc = lane + 64 * i, q = cc >> 3, dc = cc & 7; const v4u v = *(const LAS v4u*)(vst + q * 144 + dc * 16);
        *(GAS v4u*)(Q + ((size_t)b * SEQ + ((size_t)(m0 + q) << dsh) + res) * QW + gi * 1024 + h * 64 + 8 * dc) = v; }
    if (lane < 32) LSE[qrow * 48 + gi * 16 + h] = mx + __logf(lsum);
    asm volatile("s_waitcnt lgkmcnt(0)" ::: "memory");
}
__device__ __forceinline__ void attn_unit(Frame& F, int u, const float* rel_table) {
    const int b = u >> 6, h = (u >> 2) & 15, span = u & 3;
    bf16* Q = (bf16*)(F.ws + WS_BIG); const bf16* Kt = (const bf16*)F.out; const bf16* Vt = Kt + (size_t)T * D;
    float* LSE = (float*)(F.ws + WS_LSE); bf16* YA = (bf16*)(F.ws + WS_YA);
    const int tid = F.wave * 64 + lane_id();
    __syncthreads();
    for (int i = tid; i < 3 * 132; i += NWAVES * 64) { const int gi = i / 132, dl = i % 132; ((LAS float*)(F.lds + AO_BIAS))[i] = dl <= 128 ? rel_table[(int)T5_BUCKET[gi][dl] * 48 + gi * 16 + h] : 0.f; }
    __syncthreads();
#pragma unroll 1
    for (int i = 0; i < 12; ++i) {
        const int wt = F.wave + 8 * i, gi = wt >> 5, idx = wt & 31;
        const int nbk = 32 >> (2 * gi), res = idx / nbk, blk = idx % nbk, Ls = 1024 >> (2 * gi);
        attn_wave_tile(F, b, h, gi, res, span * Ls + 32 * blk, Q, Kt, Vt, LSE);
    }
    VM_WAIT();
    __syncthreads();
#pragma unroll 1
    for (int i = 0; i < 16; ++i) { const int it = tid + 512 * i, tok = it >> 3, dc = it & 7; const size_t row = (size_t)b * SEQ + span * 1024 + tok;
        const float l0 = LSE[row * 48 + h], l1 = LSE[row * 48 + 16 + h], l2 = LSE[row * 48 + 32 + h];
        const float mm = fmaxf(l0, fmaxf(l1, l2)); float w0 = __expf(l0 - mm), w1 = __expf(l1 - mm), w2 = __expf(l2 - mm); const float inv = 1.0f / (w0 + w1 + w2); w0 *= inv; w1 *= inv; w2 *= inv;
        const bf16* op = Q + row * QW + h * 64 + 8 * dc;
        const v4u a = *(const GAS v4u*)op, bq = *(const GAS v4u*)(op + 1024), cq = *(const GAS v4u*)(op + 2048);
        const unsigned aw[4] = {a.x, a.y, a.z, a.w}, bw[4] = {bq.x, bq.y, bq.z, bq.w}, cw[4] = {cq.x, cq.y, cq.z, cq.w}; unsigned ow[4];
#pragma unroll
        for (int j = 0; j < 4; ++j) ow[j] = pk2(w0 * bflo(aw[j]) + w1 * bflo(bw[j]) + w2 * bflo(cw[j]), w0 * bfhi(aw[j]) + w1 * bfhi(bw[j]) + w2 * bfhi(cw[j]));
        *(GAS v4u*)(YA + row * 3072 + 2048 + h * 64 + 8 * dc) = (v4u){ow[0], ow[1], ow[2], ow[3]}; }
}
__device__ __forceinline__ void ynorm_phase(Frame& F, const float* norm_g) {
    bf16* YA = (bf16*)(F.ws + WS_YA); const float* PSSQ = (const float*)(F.ws + WS_PSSQ);
    const int gw = F.vcu * NWAVES + F.wave, NGW = F.G * NWAVES, lane = lane_id();
    for (int m = gw; m < T; m += NGW) {
        const float ps = lane < 32 ? PSSQ[(size_t)m * 32 + lane] : 0.f;
        const float rstd = 1.0f / sqrtf(wave_sum(ps) * (1.0f / DI) + EPS);
#pragma unroll
        for (int j = 0; j < 4; ++j) { const int k = 8 * lane + 512 * j; bf16* p = YA + (size_t)m * 3072 + k;
            const v4u v = *(const GAS v4u*)p; const f32x4 g0 = *(const GAS f32x4*)(norm_g + k), g1 = *(const GAS f32x4*)(norm_g + k + 4);
            *(GAS v4u*)p = (v4u){pk2(bflo(v.x) * rstd * g0.x, bfhi(v.x) * rstd * g0.y), pk2(bflo(v.y) * rstd * g0.z, bfhi(v.y) * rstd * g0.w),
                                 pk2(bflo(v.z) * rstd * g1.x, bfhi(v.z) * rstd * g1.y), pk2(bflo(v.w) * rstd * g1.z, bfhi(v.w) * rstd * g1.w)}; }
    }
}

__device__ __forceinline__ void dwconv_phase(Frame& F, const float* w_dw, const float* b_dw, const float* ln_g, const float* ln_b) {
    const bf16* U = (const bf16*)(F.ws + WS_U); bf16* V2 = (bf16*)(F.ws + WS_V2);
    const int lane = lane_id(), tid = F.wave * 64 + lane;
    const int c0 = 2 * tid;
    float w0[31], w1[31];
#pragma unroll
    for (int k = 0; k < 31; ++k) { const float2 t = *(const float2*)(w_dw + (size_t)k * D + c0); w0[k] = t.x; w1[k] = t.y; }
    const float2 bb = *(const float2*)(b_dw + c0), lg = *(const float2*)(ln_g + c0), lb = *(const float2*)(ln_b + c0);
    LAS float* red = (LAS float*)F.lds;
    LAS float* tot = red + 512;
#pragma unroll 1
    for (int u = F.vcu; u < T / 32; u += F.G) {
        const int trow = u * 32, tb = trow & (SEQ - 1);
        float a0[32], a1[32];
#pragma unroll
        for (int o = 0; o < 32; ++o) { a0[o] = bb.x; a1[o] = bb.y; }
#pragma unroll
        for (int r = 0; r < 62; ++r) {
            unsigned raw = 0u;
            if (tb - 30 + r >= 0) raw = *(const GAS unsigned*)(U + (size_t)(trow - 30 + r) * D + c0);
            const float v0 = bflo(raw), v1 = bfhi(raw);
#pragma unroll
            for (int o = 0; o < 32; ++o) { const int k = r - o; if (k >= 0 && k <= 30) { a0[o] += w0[k] * v0; a1[o] += w1[k] * v1; } }
        }
        float v[64];
#pragma unroll
        for (int o = 0; o < 32; ++o) { v[o] = a0[o] + a1[o]; v[32 + o] = a0[o] * a0[o] + a1[o] * a1[o]; }
#pragma unroll
        for (int k = 0; k < 6; ++k) { const int half = 32 >> k; const bool up = (lane >> k) & 1;
#pragma unroll
            for (int i = 0; i < half; ++i) { const float send = up ? v[i] : v[i + half], keep = up ? v[i + half] : v[i]; v[i] = keep + __shfl_xor(send, 1 << k); } }
        const int sidx = (int)(__builtin_bitreverse32((unsigned)lane) >> 26);
        __syncthreads();
        red[F.wave * 64 + sidx] = v[0];
        __syncthreads();
        if (tid < 64) { float s = 0.f;
#pragma unroll
            for (int w8 = 0; w8 < 8; ++w8) s += red[w8 * 64 + tid];
            tot[tid] = s; }
        __syncthreads();
#pragma unroll
        for (int o = 0; o < 32; ++o) { const float mean = tot[o] * (1.0f / D), var = tot[32 + o] * (1.0f / D) - mean * mean; const float rstd = 1.0f / sqrtf(fmaxf(var, 0.f) + EPS);
            const float y0 = (a0[o] - mean) * rstd * lg.x + lb.x, y1 = (a1[o] - mean) * rstd * lg.y + lb.y;
            *(GAS unsigned*)(V2 + (size_t)(trow + o) * D + c0) = pk2(siluf(y0), siluf(y1)); }
    }
}

struct Args { const float* in[27]; float* out; unsigned char* ws; int ph_lo, ph_hi; };
__global__ void __launch_bounds__(NWAVES * 64, 2) mega_fwd(Args args) {
    extern __shared__ __attribute__((aligned(16))) unsigned char lds[];
    Frame F;
    F.lds = (LAS unsigned char*)lds;
    F.wave = __builtin_amdgcn_readfirstlane(threadIdx.x >> 6);
    F.G = gridDim.x; { const int bx = blockIdx.x; F.vcu = (F.G % 8 == 0) ? (bx % 8) * (F.G / 8) + bx / 8 : bx; }
    F.ws = args.ws; F.out = args.out; F.in = nullptr;
    volatile LAS unsigned* MISC = (volatile LAS unsigned*)(F.lds + MISC_OFF);
    if (threadIdx.x < 64) ((LAS unsigned*)(F.lds + MISC_OFF))[threadIdx.x] = 0u;
    __syncthreads();
    gu32* ctl = (gu32*)(F.ws + WS_CTL);
    XcdBarrier bar = xcd_barrier_post((unsigned*)(ctl + CW_BAR), MISC + 8, threadIdx.x == 0);
    const int lo = args.ph_lo, hi = args.ph_hi;
#define IN(k) (lo <= (k) && (k) < hi)
#define SEAM(k) do { if (IN(k) && IN((k) + 1)) xcd_barrier(bar, F.wave); } while (0)
    const float* x = args.in[0]; const float* MOD = (const float*)(F.ws + WS_MOD);
    const float* MOD0 = MOD; const float* MOD1 = MOD + 4 * 6144;
    LAS float* cscr = (LAS float*)(F.lds + F.wave * 8704);
    const int gw = F.vcu * NWAVES + F.wave, NGW = F.G * NWAVES;
    pg8::StaticOrder S;

    if (IN(0)) { p0_phase(F, args.in[1], args.in[2], args.in[3], args.in[6]); } SEAM(0);
    if (IN(1)) { p1_phase(F, x, args.in[4], args.in[9]); } SEAM(1);
    if (IN(2)) {
        pg8::Gemm g{(const bf16*)(F.ws + WS_H), (const bf16*)(F.ws + WS_WZX), T, 5120, D}; S.init(T, 5120, F.G, (int)blockIdx.x);
        pg8::EpiBf16Seg E{(bf16*)F.out, DI, 8, (bf16*)(F.ws + WS_BIG), CONVD, 1 << 30, nullptr, 0};
        pg8::gemm_phase<pg8::EpiBf16Seg, pg8::StaticOrder, true, true>(F.lds, F.wave, g, S, E);
    } SEAM(2);
    if (IN(3)) {
        if ((F.vcu & 1) == 0) { for (int u = F.vcu >> 1; u < NB * NH; u += (F.G + 1) / 2) ssd_chain(F, u >> 5, u & 31, args.in[7], args.in[8], args.in[10], args.in[11]); }
        else { const int cw = (F.vcu >> 1) * NWAVES + F.wave, ncw = (F.G / 2) * NWAVES;
            for (int it = cw; it < 160 * 16; it += ncw) cvt_win_item(args.in[6], F.ws, it / 160, 161 + it % 160, cscr, lane_id()); }
    } SEAM(3);
    if (IN(4)) {
        pg8::Gemm g{(const bf16*)(F.ws + WS_H), (const bf16*)(F.ws + WS_WQKV), T, 5120, D}; S.init(T, 5120, F.G, (int)blockIdx.x);
        pg8::EpiBf16Seg E{(bf16*)(F.ws + WS_BIG), QW, 12, (bf16*)F.out, D, 16, (bf16*)F.out + (size_t)T * D, D};
        pg8::gemm_phase<pg8::EpiBf16Seg, pg8::StaticOrder, true, true>(F.lds, F.wave, g, S, E);
    } SEAM(4);
    if (IN(5)) {
        for (int u = F.vcu; u < 256; u += F.G) attn_unit(F, u, args.in[14]);
        ynorm_phase(F, args.in[12]);
        __syncthreads();
        constexpr int I_OUT = 48 * 32, I_GU = 16 * 88, I_DN = 44 * 32, I_C1 = 16 * 32, I_C2 = 16 * 32;
        constexpr int NIT = I_OUT + 2 * (2 * I_GU + I_DN) + 2 * I_C1 + I_C2;
        const float* wg = args.in[23]; const float* wu = args.in[24]; const float* wd = args.in[25];
        for (int it = gw; it < NIT; it += NGW) { int r = it;
            if (r < I_OUT) { cvt_plain_item(args.in[13], 3072, D, (bf16*)(F.ws + WS_WOUT), r, cscr, lane_id()); continue; } r -= I_OUT;
            if (r < I_GU) { cvt_pair_item(wg, D, FH, 0, FH, 0, (bf16*)(F.ws + WS_WGU0), r, cscr, lane_id()); continue; } r -= I_GU;
            if (r < I_GU) { cvt_pair_item(wu, D, FH, 0, FH, 1, (bf16*)(F.ws + WS_WGU0), r, cscr, lane_id()); continue; } r -= I_GU;
            if (r < I_DN) { cvt_plain_item(wd, FH, D, (bf16*)(F.ws + WS_WD0), r, cscr, lane_id()); continue; } r -= I_DN;
            if (r < I_GU) { cvt_pair_item(wg + (size_t)D * FH, D, FH, 0, FH, 0, (bf16*)(F.ws + WS_WGU1), r, cscr, lane_id()); continue; } r -= I_GU;
            if (r < I_GU) { cvt_pair_item(wu + (size_t)D * FH, D, FH, 0, FH, 1, (bf16*)(F.ws + WS_WGU1), r, cscr, lane_id()); continue; } r -= I_GU;
            if (r < I_DN) { cvt_plain_item(wd + (size_t)FH * D, FH, D, (bf16*)(F.ws + WS_WD1), r, cscr, lane_id()); continue; } r -= I_DN;
            if (r < I_C1) { cvt_pair_item(args.in[15], D, 2048, 0, 1024, 0, (bf16*)(F.ws + WS_WC1), r, cscr, lane_id()); continue; } r -= I_C1;
            if (r < I_C1) { cvt_pair_item(args.in[15], D, 2048, 1024, 1024, 1, (bf16*)(F.ws + WS_WC1), r, cscr, lane_id()); continue; } r -= I_C1;
            cvt_plain_item(args.in[21], D, D, (bf16*)(F.ws + WS_WC2), r, cscr, lane_id());
        }
    } SEAM(5);
    if (IN(6)) {
        pg8::Gemm g{(const bf16*)(F.ws + WS_YA), (const bf16*)(F.ws + WS_WOUT), T, D, 3072}; S.init(T, D, F.G, (int)blockIdx.x);
        pg8::EpiRes E{x, F.out, MOD0 + 2048, nullptr};
        pg8::gemm_phase<pg8::EpiRes, pg8::StaticOrder, true, true>(F.lds, F.wave, g, S, E);
    } SEAM(6);
    if (IN(7)) { norm_phase(F, F.out, args.in[5], MOD0 + 3072, MOD0 + 4096, (bf16*)(F.ws + WS_H1)); } SEAM(7);
    if (IN(8)) {
        pg8::Gemm g{(const bf16*)(F.ws + WS_H1), (const bf16*)(F.ws + WS_WGU0), T, 2 * FH, D}; S.init(T, 2 * FH, F.G, (int)blockIdx.x);
        pg8::EpiGate<0> E{(bf16*)(F.ws + WS_HID), FH, nullptr, nullptr};
        pg8::gemm_phase<pg8::EpiGate<0>, pg8::StaticOrder, true, true>(F.lds, F.wave, g, S, E);
    } SEAM(8);
    if (IN(9)) {
        pg8::Gemm g{(const bf16*)(F.ws + WS_HID), (const bf16*)(F.ws + WS_WD0), T, D, FH}; S.init(T, D, F.G, (int)blockIdx.x);
        pg8::EpiRes E{F.out, F.out, MOD0 + 5120, nullptr};
        pg8::gemm_phase<pg8::EpiRes, pg8::StaticOrder, true, true>(F.lds, F.wave, g, S, E);
    } SEAM(9);
    if (IN(10)) { norm_phase(F, F.out, args.in[4] + D, MOD1 + 0, MOD1 + 1024, (bf16*)(F.ws + WS_H1)); } SEAM(10);
    if (IN(11)) {
        pg8::Gemm g{(const bf16*)(F.ws + WS_H1), (const bf16*)(F.ws + WS_WC1), T, 2048, D}; S.init(T, 2048, F.G, (int)blockIdx.x);
        pg8::EpiGate<1> E{(bf16*)(F.ws + WS_U), D, args.in[16], args.in[16] + 1024};
        pg8::gemm_phase<pg8::EpiGate<1>, pg8::StaticOrder, true, true>(F.lds, F.wave, g, S, E);
    } SEAM(11);
    if (IN(12)) { dwconv_phase(F, args.in[17], args.in[18], args.in[19], args.in[20]); } SEAM(12);
    if (IN(13)) {
        pg8::Gemm g{(const bf16*)(F.ws + WS_V2), (const bf16*)(F.ws + WS_WC2), T, D, D}; S.init(T, D, F.G, (int)blockIdx.x);
        pg8::EpiRes E{F.out, F.out, MOD1 + 2048, args.in[22]};
        pg8::gemm_phase<pg8::EpiRes, pg8::StaticOrder, true, true>(F.lds, F.wave, g, S, E);
    } SEAM(13);
    if (IN(14)) { norm_phase(F, F.out, args.in[5] + D, MOD1 + 3072, MOD1 + 4096, (bf16*)(F.ws + WS_H1)); } SEAM(14);
    if (IN(15)) {
        pg8::Gemm g{(const bf16*)(F.ws + WS_H1), (const bf16*)(F.ws + WS_WGU1), T, 2 * FH, D}; S.init(T, 2 * FH, F.G, (int)blockIdx.x);
        pg8::EpiGate<0> E{(bf16*)(F.ws + WS_HID), FH, nullptr, nullptr};
        pg8::gemm_phase<pg8::EpiGate<0>, pg8::StaticOrder, true, true>(F.lds, F.wave, g, S, E);
    } SEAM(15);
    if (IN(16)) {
        pg8::Gemm g{(const bf16*)(F.ws + WS_HID), (const bf16*)(F.ws + WS_WD1), T, D, FH}; S.init(T, D, F.G, (int)blockIdx.x);
        pg8::EpiRes E{F.out, F.out, MOD1 + 5120, nullptr};
        pg8::gemm_phase<pg8::EpiRes, pg8::StaticOrder, true, true>(F.lds, F.wave, g, S, E);
    } SEAM(16);
    if (IN(17)) {
        const float* fg = args.in[26];
        for (int m = gw; m < T; m += NGW) {
            const int lane = lane_id(); GAS f32x4* xr = (GAS f32x4*)(F.out + (size_t)m * D) + lane; f32x4 v[4]; float s = 0.f;
#pragma unroll
            for (int j = 0; j < 4; ++j) { v[j] = xr[64 * j]; s += (v[j].x * v[j].x + v[j].y * v[j].y) + (v[j].z * v[j].z + v[j].w * v[j].w); }
            const float rstd = 1.0f / sqrtf(wave_sum(s) * (1.0f / D) + EPS);
#pragma unroll
            for (int j = 0; j < 4; ++j) xr[64 * j] = (v[j] * rstd) * ((const GAS f32x4*)fg)[lane + 64 * j];
        }
    }
#undef IN
#undef SEAM
}

#ifndef MK_N_LAUNCHES
#define MK_N_LAUNCHES 1
#endif
extern "C" void kernel_launch(void* const* d_in, const int* in_sizes, int n_in, void* d_out, int out_size, void* d_ws, size_t ws_size, hipStream_t stream) {
    static int grid = 0;
    if (grid == 0) {
        if (n_in != 27 || in_sizes[0] != T * D || out_size != T * D || ws_size < WS_END) { fprintf(stderr, "kernel_launch: unexpected shapes (n_in %d, in0 %d, out %d, ws %zu); nothing launched\n", n_in, n_in > 0 ? in_sizes[0] : -1, out_size, ws_size); grid = -1; return; }
        int dev = 0, cus = 0, per_cu = 0;
        if (hipGetDevice(&dev) != hipSuccess || hipDeviceGetAttribute(&cus, hipDeviceAttributeMultiprocessorCount, dev) != hipSuccess) { grid = -1; return; }
        if (hipFuncSetAttribute((const void*)mega_fwd, hipFuncAttributeMaxDynamicSharedMemorySize, LDS_BYTES) != hipSuccess) { fprintf(stderr, "kernel_launch: hipFuncSetAttribute failed\n"); grid = -1; return; }
        if (hipOccupancyMaxActiveBlocksPerMultiprocessor(&per_cu, (const void*)mega_fwd, NWAVES * 64, LDS_BYTES) != hipSuccess || per_cu < 1)
            fprintf(stderr, "kernel_launch: note: occupancy query reports %d workgroups per CU\n", per_cu);
        (void)hipGetLastError();
        grid = cus;
    }
    if (grid < 0) return;
    if (hipMemsetAsync((char*)d_ws + WS_CTL, 0, CTL_ZERO_BYTES, stream) != hipSuccess) { fprintf(stderr, "kernel_launch: memset failed\n"); return; }
    Args a{};
    for (int i = 0; i < 27; ++i) a.in[i] = (const float*)d_in[i];
    a.out = (float*)d_out; a.ws = (unsigned char*)d_ws;
#if MK_N_LAUNCHES == 1
    a.ph_lo = 0; a.ph_hi = N_PHASES;
    hipLaunchKernelGGL(mega_fwd, dim3(grid), dim3(NWAVES * 64), LDS_BYTES, stream, a);
#else
    for (int p = 0; p < N_PHASES; ++p) { a.ph_lo = p; a.ph_hi = p + 1; hipLaunchKernelGGL(mega_fwd, dim3(grid), dim3(NWAVES * 64), LDS_BYTES, stream, a); }
#endif
    const hipError_t le = hipPeekAtLastError();
    if (le != hipSuccess) fprintf(stderr, "kernel_launch: launch failed: %s (grid %d)\n", hipGetErrorName(le), grid);
}
```

```cpp
#include <hip/hip_runtime.h>
#include <cstdio>
#include <cstdint>

__device__ __forceinline__ int lane_id() { int l; asm volatile("v_mbcnt_lo_u32_b32 %0, -1, 0\n\tv_mbcnt_hi_u32_b32 %0, -1, %0" : "=v"(l)); return l; }
namespace pg8 {
#define PG8_LAS __attribute__((address_space(3)))
typedef unsigned short bf16_t;
typedef short bf16x8 __attribute__((ext_vector_type(8)));
typedef float f32x4 __attribute__((ext_vector_type(4)));
typedef unsigned u32x4 __attribute__((ext_vector_type(4)));
constexpr int BM = 256, BK = 64, HALF = 128, HTB = HALF * BK * 2, STAGE_BYTES = 8 * HTB, NXCD = 8, WGM = 8;

__host__ __device__ __forceinline__ int lds_byte(int r, int c) { const int st = (r >> 4) * 2 + (c >> 5), rr = r & 15, cc = c & 31, ob = rr * 64 + cc * 2; return st * 1024 + (ob ^ (((ob >> 9) & 1) << 5)); }
__host__ __device__ __forceinline__ void stage_rc(int b, int& R, int& C) { const int st = b / 1024, sb = b % 1024, swz = sb ^ (((sb >> 9) & 1) << 5); R = (st >> 1) * 16 + swz / 64; C = (st & 1) * 32 + (swz % 64) / 2; }
__host__ __device__ __forceinline__ int perm32(int rho) { const int n = rho >> 4, i = rho & 15; return 8 * (i >> 2) + 4 * n + (i & 3); }

struct Unit { int pm, pn; };
struct Gemm { const bf16_t* A; const bf16_t* Bt; int M, N, K; };

struct StaticOrder {
    int nM, nN, nwg, G, c;
    __host__ __device__ void init(int M, int N, int G_, int c_) { nM = M / BM; nN = N / BM; nwg = nM * nN; G = G_; c = c_; }
    __host__ __device__ bool next(int i, Unit& u) const {
        const long L = (long)i * G + c; if (L >= nwg) return false;
        int wgid = (int)L; { const int q = nwg / NXCD, r = nwg % NXCD, xcd = wgid % NXCD, off = wgid / NXCD; wgid = (xcd < r ? xcd * (q + 1) : r * (q + 1) + (xcd - r) * q) + off; }
        const int nig = WGM * nN, gid = wgid / nig, fm = gid * WGM, gsz = (nM - fm) < WGM ? (nM - fm) : WGM;
        u.pm = fm + ((wgid % nig) % gsz); u.pn = (wgid % nig) / gsz; return true;
    }
    __device__ __forceinline__ void a_ready(const Unit&) const {}
    __device__ __forceinline__ void done(const Unit&) const {}
};

__device__ __forceinline__ unsigned cvt_pk_bf16(float lo, float hi) { unsigned r; asm volatile("v_cvt_pk_bf16_f32 %0, %1, %2" : "=v"(r) : "v"(lo), "v"(hi)); return r; }

struct EpiBf16Seg {
    static constexpr bool PERM = true, AFTER_DRAIN = false;
    bf16_t* O0; int ld0; int t1; bf16_t* O1; int ld1; int t2; bf16_t* O2; int ld2;
    bf16_t* halo;
    __device__ __forceinline__ void operator()(const f32x4 (&acc)[2][2][4][2], const Unit& u, int wr, int wc, int fr, int fq) const {
        bf16_t* base; int ld, ct;
        if (u.pn < t1) { base = O0; ld = ld0; ct = u.pn; } else if (u.pn < t2) { base = O1; ld = ld1; ct = u.pn - t1; } else { base = O2; ld = ld2; ct = u.pn - t2; }
        const int row0 = u.pm * BM + wr * 64 + fr, col0 = ct * BM + wc * 32 + 8 * fq;
        const bool do_halo = halo && u.pn >= t1 && u.pn < t2 && ct >= 8 && wr == 1 && fr >= 13;
#pragma unroll
        for (int ai = 0; ai < 2; ++ai)
#pragma unroll
            for (int m = 0; m < 4; ++m) { bf16_t* rowp = base + (size_t)(row0 + ai * HALF + m * 16) * ld + col0;
#pragma unroll
                for (int bj = 0; bj < 2; ++bj) { const f32x4 v0 = acc[ai][bj][m][0], v1 = acc[ai][bj][m][1];
                    u32x4 w; w.x = cvt_pk_bf16(v0[0], v0[1]); w.y = cvt_pk_bf16(v0[2], v0[3]); w.z = cvt_pk_bf16(v1[0], v1[1]); w.w = cvt_pk_bf16(v1[2], v1[3]);
                    *(u32x4*)(rowp + bj * HALF) = w;
                    if (m == 3 && do_halo) *(u32x4*)(halo + ((size_t)((u.pm * 2 + ai) * 3 + (fr - 13))) * 1024 + (col0 - 2048) + bj * HALF) = w; } }
    }
};
__device__ __forceinline__ float sigm(float v) { return __builtin_amdgcn_rcpf(1.0f + __builtin_amdgcn_exp2f(-1.4426950408889634f * v)); }
template <int MODE> struct EpiGate {
    static constexpr bool PERM = true, AFTER_DRAIN = false;
    bf16_t* O; int ldc; const float* ba; const float* bg;
    __device__ __forceinline__ void operator()(const f32x4 (&acc)[2][2][4][2], const Unit& u, int wr, int wc, int fr, int fq) const {
        const int row0 = u.pm * BM + wr * 64 + fr, col0 = u.pn * HALF + wc * 32 + 8 * fq;
        f32x4 bav[2], bgv[2];
#pragma unroll
        for (int n = 0; n < 2; ++n) { if (MODE == 1) { bav[n] = *(const f32x4*)(ba + col0 + 4 * n); bgv[n] = *(const f32x4*)(bg + col0 + 4 * n); } else { bav[n] = (f32x4){0.f, 0.f, 0.f, 0.f}; bgv[n] = bav[n]; } }
#pragma unroll
        for (int ai = 0; ai < 2; ++ai)
#pragma unroll
            for (int m = 0; m < 4; ++m) { bf16_t* rowp = O + (size_t)(row0 + ai * HALF + m * 16) * ldc + col0; float r[8];
#pragma unroll
                for (int n = 0; n < 2; ++n)
#pragma unroll
                    for (int j = 0; j < 4; ++j) { const float a = acc[ai][0][m][n][j] + bav[n][j], b = acc[ai][1][m][n][j] + bgv[n][j];
                        r[4 * n + j] = (MODE == 0) ? a * sigm(a) * b : a * sigm(b); }
                u32x4 w; w.x = cvt_pk_bf16(r[0], r[1]); w.y = cvt_pk_bf16(r[2], r[3]); w.z = cvt_pk_bf16(r[4], r[5]); w.w = cvt_pk_bf16(r[6], r[7]);
                *(u32x4*)rowp = w; }
    }
};
struct EpiRes {
    static constexpr bool PERM = false, AFTER_DRAIN = false;
    const float* base; float* out; const float* gate; const float* bias;
    __device__ __forceinline__ void operator()(const f32x4 (&acc)[2][2][4][2], const Unit& u, int wr, int wc, int fr, int fq) const {
        const int row0 = u.pm * BM + wr * 64 + fr, col0 = u.pn * BM + wc * 32 + 4 * fq;
        const float* gp = gate + (size_t)(u.pm >> 4) * 6144 + col0;
        f32x4 gv[2][2], bv[2][2];
#pragma unroll
        for (int bj = 0; bj < 2; ++bj)
#pragma unroll
            for (int n = 0; n < 2; ++n) { gv[bj][n] = *(const f32x4*)(gp + bj * HALF + n * 16); bv[bj][n] = bias ? *(const f32x4*)(bias + col0 + bj * HALF + n * 16) : (f32x4){0.f, 0.f, 0.f, 0.f}; }
#pragma unroll
        for (int ai = 0; ai < 2; ++ai)
#pragma unroll
            for (int m = 0; m < 4; ++m) { const size_t off = (size_t)(row0 + ai * HALF + m * 16) * 1024 + col0;
#pragma unroll
                for (int bj = 0; bj < 2; ++bj)
#pragma unroll
                    for (int n = 0; n < 2; ++n) { const f32x4 bs = *(const f32x4*)(base + off + bj * HALF + n * 16);
                        *(f32x4*)(out + off + bj * HALF + n * 16) = bs + gv[bj][n] * (acc[ai][bj][m][n] + bv[bj][n]); }
                if (m & 1) asm volatile("" ::: "memory"); }
    }
};

template <class Epi, class Sched, bool ALIGN_EPI = false, bool SP2 = false>
__device__ __forceinline__ void gemm_phase(PG8_LAS unsigned char* lds, int wid, const Gemm g, const Sched& S, const Epi& E) {
    const int lane = lane_id(), tid = wid * 64 + lane, wr = wid >> 2, wc = wid & 3, fr = lane & 15, fq = lane >> 4;
    const int K = g.K, nt = K / BK;
    unsigned voffA[2], voffB[2];
#pragma unroll
    for (int i = 0; i < 2; ++i) { int R, C; stage_rc(tid * 16 + i * 8192, R, C); const int Rb = Epi::PERM ? ((R & ~31) + perm32(R & 31)) : R;
        voffA[i] = (unsigned)(R * K + C) * 2u; voffB[i] = (unsigned)(Rb * K + C) * 2u; }
    const size_t kstep = (size_t)(BK * 2);
    const size_t hstep = (size_t)HALF * K * 2;
    const size_t tstep = 2 * hstep;
    const unsigned ldsw = (unsigned)wid * 1024u;
    const int aoff = lds_byte(wr * 64 + fr, fq * 8), boff = lds_byte(wc * 32 + fr, fq * 8);
#define PG8_SA(b, h) (((b) * 2 + (h)) * HTB)
#define PG8_SB(b, h) ((4 + (b) * 2 + (h)) * HTB)
#define PG8_STAGE(bufoff, gbase, voff) do { _Pragma("unroll") for (int _i = 0; _i < 2; ++_i) \
        __builtin_amdgcn_global_load_lds((const unsigned*)((const char*)(gbase) + (voff)[_i]), (PG8_LAS unsigned*)(lds + (bufoff) + ldsw + _i * 8192), 16, 0, 0); } while (0)
#define PG8_LDA(dst, b, h) do { _Pragma("unroll") for (int m = 0; m < 4; ++m) _Pragma("unroll") for (int k = 0; k < 2; ++k) dst[m][k] = *(const PG8_LAS bf16x8*)(lds + PG8_SA(b, h) + aoff + m * 2048 + k * 1024); } while (0)
#define PG8_LDB(dst, b, h) do { _Pragma("unroll") for (int n = 0; n < 2; ++n) _Pragma("unroll") for (int k = 0; k < 2; ++k) dst[n][k] = *(const PG8_LAS bf16x8*)(lds + PG8_SB(b, h) + boff + n * 2048 + k * 1024); } while (0)
#define PG8_MMA(ai, bj, At, Bt) do { __builtin_amdgcn_s_setprio(1); _Pragma("unroll") for (int m = 0; m < 4; ++m) _Pragma("unroll") for (int n = 0; n < 2; ++n) _Pragma("unroll") for (int k = 0; k < 2; ++k) \
        acc[ai][bj][m][n] = __builtin_amdgcn_mfma_f32_16x16x32_bf16(Bt[n][k], At[m][k], acc[ai][bj][m][n], 0, 0, 0); __builtin_amdgcn_s_setprio(0); } while (0)
#define PG8_WAIT_V(n) asm volatile("s_waitcnt vmcnt(" #n ")" ::: "memory")
#define PG8_WAIT_L(n) asm volatile("s_waitcnt lgkmcnt(" #n ")" ::: "memory")
#define PG8_BAR __builtin_amdgcn_s_barrier()
#define PG8_SCHED __builtin_amdgcn_sched_barrier(0)
    Unit cur, nxt; int ui = 0;
    if (!S.next(0, cur)) return;
    f32x4 acc[2][2][4][2];
#pragma unroll
    for (int a = 0; a < 2; ++a)
#pragma unroll
        for (int b = 0; b < 2; ++b)
#pragma unroll
            for (int m = 0; m < 4; ++m)
#pragma unroll
                for (int n = 0; n < 2; ++n) acc[a][b][m][n] = (f32x4){0.f, 0.f, 0.f, 0.f};
    bf16x8 At[4][2], B0[2][2], B1[2][2];
    const char* cA = (const char*)g.A + (size_t)cur.pm * tstep; const char* cB = (const char*)g.Bt + (size_t)cur.pn * tstep;
    S.a_ready(cur);
    if constexpr (SP2) {
        PG8_STAGE(PG8_SB(0, 0), cB, voffB); PG8_STAGE(PG8_SB(0, 1), cB + hstep, voffB); PG8_STAGE(PG8_SA(0, 0), cA, voffA); PG8_STAGE(PG8_SA(0, 1), cA + hstep, voffA);
        if (wr == 1) PG8_BAR;
        PG8_WAIT_V(2); PG8_BAR;
        PG8_STAGE(PG8_SB(1, 0), cB + kstep, voffB); PG8_STAGE(PG8_SA(1, 0), cA + kstep, voffA); PG8_STAGE(PG8_SB(1, 1), cB + hstep + kstep, voffB);
        PG8_WAIT_V(6); PG8_BAR;
    } else {
        PG8_STAGE(PG8_SB(0, 0), cB, voffB); PG8_STAGE(PG8_SA(0, 0), cA, voffA); PG8_STAGE(PG8_SB(0, 1), cB + hstep, voffB); PG8_STAGE(PG8_SA(0, 1), cA + hstep, voffA);
        if (wr == 1) PG8_BAR;
        PG8_WAIT_V(4); PG8_BAR;
        PG8_STAGE(PG8_SB(1, 0), cB + kstep, voffB); PG8_STAGE(PG8_SA(1, 0), cA + kstep, voffA); PG8_STAGE(PG8_SB(1, 1), cB + hstep + kstep, voffB);
        PG8_WAIT_V(6); PG8_BAR;
    }
    for (;;) {
        const bool has_next = S.next(ui + 1, nxt);
        const char* nA = has_next ? (const char*)g.A + (size_t)nxt.pm * tstep : cA; const char* nB = has_next ? (const char*)g.Bt + (size_t)nxt.pn * tstep : cB;
        for (int t = 0; t < nt; t += 2) {
            const bool last = (t == nt - 2);
            const char* a1 = cA + (size_t)(t + 1) * kstep;
            const char* a2 = last ? nA : cA + (size_t)(t + 2) * kstep; const char* b2 = last ? nB : cB + (size_t)(t + 2) * kstep;
            const char* a3 = a2 + kstep; const char* b3 = b2 + kstep;
            if (last && has_next) S.a_ready(nxt);
            if constexpr (SP2) {
            PG8_LDB(B0, 0, 0); PG8_LDB(B1, 0, 1); PG8_SCHED; PG8_LDA(At, 0, 0); PG8_STAGE(PG8_SA(1, 1), a1 + hstep, voffA);
            PG8_WAIT_V(8); PG8_WAIT_L(0); PG8_BAR; PG8_MMA(0, 0, At, B0); PG8_MMA(0, 1, At, B1); PG8_BAR; PG8_SCHED;
            PG8_LDA(At, 0, 1); PG8_STAGE(PG8_SB(0, 0), b2, voffB); PG8_STAGE(PG8_SB(0, 1), b2 + hstep, voffB); PG8_STAGE(PG8_SA(0, 0), a2, voffA);
            PG8_WAIT_V(8); PG8_WAIT_L(0); PG8_BAR; PG8_MMA(1, 0, At, B0); PG8_MMA(1, 1, At, B1); PG8_BAR; PG8_SCHED;
            PG8_LDB(B0, 1, 0); PG8_LDB(B1, 1, 1); PG8_SCHED; PG8_LDA(At, 1, 0); PG8_STAGE(PG8_SA(0, 1), a2 + hstep, voffA);
            PG8_WAIT_V(8); PG8_WAIT_L(0); PG8_BAR; PG8_MMA(0, 0, At, B0); PG8_MMA(0, 1, At, B1); PG8_BAR; PG8_SCHED;
            PG8_LDA(At, 1, 1); PG8_STAGE(PG8_SB(1, 0), b3, voffB); PG8_STAGE(PG8_SB(1, 1), b3 + hstep, voffB); PG8_STAGE(PG8_SA(1, 0), a3, voffA);
            PG8_WAIT_V(8); PG8_WAIT_L(0); PG8_BAR; PG8_MMA(1, 0, At, B0); PG8_MMA(1, 1, At, B1); PG8_BAR; PG8_SCHED;
            } else {
            PG8_LDB(B0, 0, 0); PG8_SCHED; PG8_LDA(At, 0, 0); PG8_STAGE(PG8_SA(1, 1), a1 + hstep, voffA);
            PG8_WAIT_L(8); PG8_BAR; PG8_WAIT_L(0); PG8_MMA(0, 0, At, B0); PG8_BAR; PG8_SCHED;
            PG8_LDB(B1, 0, 1); PG8_STAGE(PG8_SB(0, 0), b2, voffB);
            PG8_BAR; PG8_WAIT_L(0); PG8_MMA(0, 1, At, B1); PG8_BAR;
            PG8_LDA(At, 0, 1); PG8_STAGE(PG8_SA(0, 0), a2, voffA);
            PG8_BAR; PG8_WAIT_L(0); PG8_MMA(1, 0, At, B0); PG8_BAR; PG8_SCHED;
            PG8_STAGE(PG8_SB(0, 1), b2 + hstep, voffB);
            PG8_WAIT_V(6); PG8_BAR; PG8_MMA(1, 1, At, B1); PG8_BAR;
            PG8_LDB(B0, 1, 0); PG8_SCHED; PG8_LDA(At, 1, 0); PG8_STAGE(PG8_SA(0, 1), a2 + hstep, voffA);
            PG8_WAIT_L(8); PG8_BAR; PG8_WAIT_L(0); PG8_MMA(0, 0, At, B0); PG8_BAR; PG8_SCHED;
            PG8_LDB(B1, 1, 1); PG8_STAGE(PG8_SB(1, 0), b3, voffB);
            PG8_BAR; PG8_WAIT_L(0); PG8_MMA(0, 1, At, B1); PG8_BAR;
            PG8_LDA(At, 1, 1); PG8_STAGE(PG8_SA(1, 0), a3, voffA);
            PG8_BAR; PG8_WAIT_L(0); PG8_MMA(1, 0, At, B0); PG8_BAR; PG8_SCHED;
            PG8_STAGE(PG8_SB(1, 1), b3 + hstep, voffB);
            PG8_WAIT_V(6); PG8_BAR; PG8_MMA(1, 1, At, B1); PG8_BAR;
            }
        }
        if constexpr (ALIGN_EPI) { if (wr == 0) PG8_BAR; }
        if constexpr (!Epi::AFTER_DRAIN) { E(acc, cur, wr, wc, fr, fq); S.done(cur); }
        if (!has_next) break;
#pragma unroll
        for (int a = 0; a < 2; ++a)
#pragma unroll
            for (int b = 0; b < 2; ++b)
#pragma unroll
                for (int m = 0; m < 4; ++m)
#pragma unroll
                    for (int n = 0; n < 2; ++n) acc[a][b][m][n] = (f32x4){0.f, 0.f, 0.f, 0.f};
        cur = nxt; cA = nA; cB = nB; ++ui;
        if constexpr (ALIGN_EPI) { if (wr == 1) PG8_BAR; }
    }
    PG8_WAIT_V(0);
    if constexpr (!ALIGN_EPI) { if (wr == 0) PG8_BAR; }
    PG8_BAR;
#undef PG8_SA
#undef PG8_SB
#undef PG8_STAGE
#undef PG8_LDA
#undef PG8_LDB
#undef PG8_MMA
#undef PG8_WAIT_V
#undef PG8_WAIT_L
#undef PG8_BAR
#undef PG8_SCHED
}
}

constexpr int NWAVES = 8;
constexpr int NB = 4, SEQ = 4096, D = 1024, T = NB * SEQ;
constexpr int DI = 2048, NH = 32, HP = 64, NS = 128, CONVD = 3072, CHUNK = 128, NCHUNK = SEQ / CHUNK;
constexpr int AH = 16, AHD = 64, QW = 3072;
constexpr int FH = 2816;
constexpr int N_PHASES = 18;
constexpr float EPS = 1e-6f;

constexpr size_t MiB = 1u << 20;
constexpr size_t WS_CTL = 0, CTL_ZERO_BYTES = 1 * MiB;
constexpr size_t WS_MOD = 1 * MiB;
constexpr size_t WS_DT = 2 * MiB;
constexpr size_t WS_LSE = 4 * MiB;
constexpr size_t WS_PSSQ = 7 * MiB;
constexpr size_t WS_WDT = 9 * MiB;
constexpr size_t WS_WZX = 10 * MiB;
constexpr size_t WS_WQKV = 20 * MiB;
constexpr size_t WS_H = 30 * MiB;
constexpr size_t WS_BIG = 62 * MiB;
constexpr size_t WS_YA = 158 * MiB;
constexpr size_t WS_WOUT = 10 * MiB;
constexpr size_t WS_WGU0 = 16 * MiB;
constexpr size_t WS_WD0 = 27 * MiB;
constexpr size_t WS_WC1 = 33 * MiB;
constexpr size_t WS_WC2 = 37 * MiB;
constexpr size_t WS_WGU1 = 39 * MiB;
constexpr size_t WS_WD1 = 50 * MiB;
constexpr size_t WS_H1 = 62 * MiB;
constexpr size_t WS_HID = 94 * MiB;
constexpr size_t WS_U = 182 * MiB;
constexpr size_t WS_V2 = 214 * MiB;
constexpr size_t WS_HALO = 254 * MiB;
constexpr size_t WS_END = 256 * MiB;
constexpr int CW_BAR = 4096;

constexpr int LDS_BYTES = 163840;
constexpr int MISC_OFF = LDS_BYTES - 256;

#define GAS __attribute__((address_space(1)))
#define LAS __attribute__((address_space(3)))
typedef unsigned short bf16;
typedef unsigned v4u __attribute__((ext_vector_type(4)));
typedef unsigned v2u __attribute__((ext_vector_type(2)));
typedef float f32x4 __attribute__((ext_vector_type(4)));
typedef float f32x16 __attribute__((ext_vector_type(16)));
typedef short bf16x8 __attribute__((ext_vector_type(8)));
typedef short s16x4 __attribute__((ext_vector_type(4)));
typedef GAS unsigned gu32;
#define RLX_AGENT __ATOMIC_RELAXED, __HIP_MEMORY_SCOPE_AGENT
#define LDS_WAIT() asm volatile("s_waitcnt lgkmcnt(0)" ::: "memory")
#define VM_WAIT() asm volatile("s_waitcnt vmcnt(0)" ::: "memory")
__device__ __forceinline__ unsigned f2bf(float f) { unsigned u = __builtin_bit_cast(unsigned, f); return (u + 0x7fffu + ((u >> 16) & 1u)) >> 16; }
typedef float f32x2_t __attribute__((ext_vector_type(2))); typedef __bf16 bf16x2_t __attribute__((ext_vector_type(2)));
__device__ __forceinline__ unsigned pk2(float lo, float hi) { f32x2_t v = {lo, hi}; bf16x2_t b = __builtin_convertvector(v, bf16x2_t); return __builtin_bit_cast(unsigned, b); }
__device__ __forceinline__ float bflo(unsigned w) { return __builtin_bit_cast(float, w << 16); }
__device__ __forceinline__ float bfhi(unsigned w) { return __builtin_bit_cast(float, w & 0xffff0000u); }
__device__ __forceinline__ float fexp(float v) { return __builtin_amdgcn_exp2f(1.4426950408889634f * v); }
__device__ __forceinline__ float siluf(float v) { return v * __builtin_amdgcn_rcpf(1.0f + fexp(-v)); }

__device__ const unsigned char T5_BUCKET[3][132] = {
{0,1,2,3,4,5,6,7,8,9,10,11,12,13,14,15,16,16,16,16,16,16,17,17,17,17,17,17,17,17,18,18,18,18,18,18,18,18,18,18,19,19,19,19,19,19,19,19,19,19,19,19,19,19,20,20,20,20,20,20,20,20,20,20,20,20,20,20,20,20,20,20,20,21,21,21,21,21,21,21,21,21,21,21,21,21,21,21,21,21,21,21,21,21,21,21,21,21,21,22,22,22,22,22,22,22,22,22,22,22,22,22,22,22,22,22,22,22,22,22,22,22,22,22,22,22,22,22,22},
{0,4,8,12,16,16,17,17,18,18,19,19,19,19,20,20,20,20,20,21,21,21,21,21,21,22,22,22,22,22,22,22,22,22,23,23,23,23,23,23,23,23,23,23,23,23,24,24,24,24,24,24,24,24,24,24,24,24,24,24,24,24,25,25,25,25,25,25,25,25,25,25,25,25,25,25,25,25,25,25,25,25,25,26,26,26,26,26,26,26,26,26,26,26,26,26,26,26,26,26,26,26,26,26,26,26,26,26,26,26,26,26,26,27,27,27,27,27,27,27,27,27,27,27,27,27,27,27,27},
{0,16,18,19,20,21,21,22,22,23,23,23,24,24,24,24,25,25,25,25,25,26,26,26,26,26,26,26,26,27,27,27,27,27,27,27,27,27,27,28,28,28,28,28,28,28,28,28,28,28,28,28,29,29,29,29,29,29,29,29,29,29,29,29,29,29,29,29,29,29,30,30,30,30,30,30,30,30,30,30,30,30,30,30,30,30,30,30,30,30,30,30,30,30,30,31,31,31,31,31,31,31,31,31,31,31,31,31,31,31,31,31,31,31,31,31,31,31,31,31,31,31,31,31,31,31,31,31,31}};

#define XB_TMO      128
#define XB_XCNT(j)  (256  + 64 * (j))
#define XB_XSUB(j)  (1280 + 64 * (j))
#define XB_XGEN(j)  (2304 + 64 * (j))
#define XB_TOP      3328
#define XB_TOPGEN   3392
#define XCD_BAR_WORDS 3456
#define XB_SPIN_CAP (1u << 18)
__device__ __forceinline__ unsigned xb_ld(unsigned* p)              { return __hip_atomic_load(p, __ATOMIC_RELAXED, __HIP_MEMORY_SCOPE_AGENT); }
__device__ __forceinline__ unsigned xb_add(unsigned* p, unsigned v) { return __hip_atomic_fetch_add(p, v, __ATOMIC_RELAXED, __HIP_MEMORY_SCOPE_AGENT); }
__device__ __forceinline__ unsigned xb_xcc_id() { return (unsigned)__builtin_amdgcn_s_getreg((3 << 11) | 20) & 0xFu; }
#define XB_SPIN(cond, bar) do { unsigned _sp = 0; while (cond) { __builtin_amdgcn_s_sleep(1); \
    if ((++_sp & 255u) == 0u) { if (xb_ld(&(bar)[XB_TMO])) break; if (_sp > XB_SPIN_CAP) { atomicAdd(&(bar)[XB_TMO], 1u); break; } } } } while (0)
struct XcdBarrier { unsigned* bar; unsigned x; volatile LAS unsigned* st; };
__device__ __forceinline__ XcdBarrier xcd_barrier_post(unsigned* bar, volatile LAS unsigned* st, bool leader) {
    XcdBarrier b; b.bar = bar; b.x = xb_xcc_id(); b.st = st;
    if (leader) (void)xb_add(&bar[XB_XCNT(b.x)], 1u);
    return b;
}
__device__ __forceinline__ void xcd_barrier_complete(unsigned* bar, unsigned x, unsigned& nloc, unsigned& nx) {
    const unsigned G = gridDim.x * gridDim.y * gridDim.z;
    unsigned sum, cnt, mine, sp = 0u;
    for (;;) {
        sum = 0u; cnt = 0u; mine = 0u;
#pragma unroll
        for (unsigned j = 0; j < 16; ++j) { const unsigned c = xb_ld(&bar[XB_XCNT(j)]); sum += c; cnt += (c > 0u) ? 1u : 0u; mine = (j == x) ? c : mine; }
        if (sum == G) break;
        __builtin_amdgcn_s_sleep(1);
        if ((++sp & 255u) == 0u) { if (xb_ld(&bar[XB_TMO])) break; if (sp > XB_SPIN_CAP) { atomicAdd(&bar[XB_TMO], 1u); break; } }
    }
    nloc = mine > 0u ? mine : 1u; nx = cnt > 0u ? cnt : 1u;
}
__device__ __forceinline__ void xcd_barrier(const XcdBarrier& b, int wave) {
    asm volatile("s_waitcnt vmcnt(0)" ::: "memory");
    __syncthreads();
    if (wave == 0 && lane_id() == 0) {
        unsigned* bar = b.bar;
        __builtin_amdgcn_s_waitcnt(0);
        unsigned nloc = b.st[0], nx = b.st[1];
        if (nloc == 0u) { xcd_barrier_complete(bar, b.x, nloc, nx); b.st[0] = nloc; b.st[1] = nx; }
        const unsigned old = xb_add(&bar[XB_XSUB(b.x)], 1u);
        const unsigned gen = old / nloc;
        if (old + 1u == (gen + 1u) * nloc) {
            __builtin_amdgcn_fence(__ATOMIC_RELEASE, "agent");
            asm volatile("s_waitcnt vmcnt(0)" ::: "memory");
            const unsigned og = xb_add(&bar[XB_TOP], 1u);
            const unsigned tg = og / nx;
            if (og + 1u == (tg + 1u) * nx) xb_add(&bar[XB_TOPGEN], 1u);
            else XB_SPIN(xb_ld(&bar[XB_TOPGEN]) == tg, bar);
            __builtin_amdgcn_fence(__ATOMIC_ACQUIRE, "agent");
            xb_add(&bar[XB_XGEN(b.x)], 1u);
            asm volatile("s_waitcnt vmcnt(0)" ::: "memory");
        } else {
            XB_SPIN(xb_ld(&bar[XB_XGEN(b.x)]) == gen, bar);
            __builtin_amdgcn_fence(__ATOMIC_ACQUIRE, "agent");
            asm volatile("s_waitcnt vmcnt(0)" ::: "memory");
        }
    }
    __syncthreads();
}

struct Frame {
    LAS unsigned char* lds;
    int wave;
    int vcu, G;
    const float* const* in;
    unsigned char* ws; float* out;
};
template <int K> __device__ __forceinline__ float swz_xor(float v) { return __builtin_bit_cast(float, __builtin_amdgcn_ds_swizzle(__builtin_bit_cast(int, v), 0x1f | (K << 10))); }
__device__ __forceinline__ float frsq(float v) { return __builtin_amdgcn_rsqf(v); }
__device__ __forceinline__ float wave_sum(float v) {
#pragma unroll
    for (int o = 1; o < 64; o <<= 1) v += __shfl_xor(v, o);
    return v;
}
__device__ __forceinline__ int rowidx(int r, int hh) { return (r & 3) + 8 * (r >> 2) + 4 * hh; }

__device__ __forceinline__ void transpose_block(const float* Wsrc, int N, bf16* dst, int Kd, LAS float* scr, int lane) {
#pragma unroll 8
    for (int i = 0; i < 32; ++i) { const int kk = 2 * i + (lane >> 5); scr[kk * 33 + (lane & 31)] = Wsrc[(size_t)kk * N + (lane & 31)]; }
    LDS_WAIT(); asm volatile("" ::: "memory");
    const int c = lane & 7;
#pragma unroll
    for (int j = 0; j < 4; ++j) { const int n = (lane >> 3) + 8 * j; const LAS float* s = scr + (8 * c) * 33 + n;
        v4u o; o.x = pk2(s[0 * 33], s[1 * 33]); o.y = pk2(s[2 * 33], s[3 * 33]); o.z = pk2(s[4 * 33], s[5 * 33]); o.w = pk2(s[6 * 33], s[7 * 33]);
        *(GAS v4u*)(dst + (size_t)n * Kd + 8 * c) = o; }
    LDS_WAIT(); asm volatile("" ::: "memory");
}
__device__ __forceinline__ void cvt_win_item(const float* w_in, unsigned char* ws, int kb, int nb, LAS float* scr, int lane) {
    const int n0 = 32 * nb; bf16* dst;
    if (n0 < 5120) dst = (bf16*)(ws + WS_WZX) + (size_t)n0 * 1024;
    else if (n0 == 5120) dst = (bf16*)(ws + WS_WDT);
    else dst = (bf16*)(ws + WS_WQKV) + (size_t)(n0 - 5152) * 1024;
    transpose_block(w_in + (size_t)(64 * kb) * 10272 + n0, 10272, dst + 64 * kb, 1024, scr, lane);
}
__device__ __forceinline__ void cvt_plain_item(const float* W, int K, int N, bf16* WT, int item, LAS float* scr, int lane) {
    const int nblk = N / 32, kb = item / nblk, nb = item % nblk;
    transpose_block(W + (size_t)(64 * kb) * N + 32 * nb, N, WT + (size_t)(32 * nb) * K + 64 * kb, K, scr, lane);
}
__device__ __forceinline__ void cvt_pair_item(const float* W, int K, int Nsrc, int coff, int Nhalf, int sel, bf16* WT, int item, LAS float* scr, int lane) {
    const int nblk = Nhalf / 32, kb = item / nblk, nb = item % nblk, n0 = 32 * nb;
    const int drow = (n0 >> 7) * 256 + sel * 128 + (n0 & 127);
    transpose_block(W + (size_t)(64 * kb) * Nsrc + coff + n0, Nsrc, WT + (size_t)drow * K + 64 * kb, K, scr, lane);
}

__device__ __forceinline__ void adaln_row(const float* xrow, const float* g, const float* sc, const float* sh, int lane, unsigned (&pk)[4][2]) {
    const GAS f32x4* xr = (const GAS f32x4*)xrow + lane;
    f32x4 v[4]; float s = 0.f;
#pragma unroll
    for (int j = 0; j < 4; ++j) { v[j] = xr[64 * j]; s += (v[j].x * v[j].x + v[j].y * v[j].y) + (v[j].z * v[j].z + v[j].w * v[j].w); }
    const float rstd = frsq(wave_sum(s) * (1.0f / D) + EPS);
#pragma unroll
    for (int j = 0; j < 4; ++j) {
        const f32x4 gv = ((const GAS f32x4*)g)[lane + 64 * j], scv = ((const GAS f32x4*)sc)[lane + 64 * j], shv = ((const GAS f32x4*)sh)[lane + 64 * j];
        const f32x4 hv = (v[j] * rstd) * gv * (scv + 1.0f) + shv;
        pk[j][0] = pk2(hv.x, hv.y); pk[j][1] = pk2(hv.z, hv.w);
    }
}
__device__ __forceinline__ void norm_phase(Frame& F, const float* X, const float* g, const float* modsh, const float* modsc, bf16* out) {
    const int gw = F.vcu * NWAVES + F.wave, NGW = F.G * NWAVES, lane = lane_id();
    for (int m = gw; m < T; m += NGW) {
        const int b = m >> 12; unsigned pk[4][2];
        adaln_row(X + (size_t)m * D, g, modsc + (size_t)b * 6144, modsh + (size_t)b * 6144, lane, pk);
        GAS v2u* o8 = (GAS v2u*)(out + (size_t)m * D) + lane;
#pragma unroll
        for (int j = 0; j < 4; ++j) o8[64 * j] = (v2u){pk[j][0], pk[j][1]};
    }
}

__device__ __forceinline__ void p0_phase(Frame& F, const float* c, const float* ada_w, const float* ada_b, const float* w_in) {
    LAS float* cs = (LAS float*)(F.lds);
    LAS float* red = (LAS float*)(F.lds + 16384);
    float* MOD = (float*)(F.ws + WS_MOD);
    const int lane = lane_id(), tid = F.wave * 64 + lane;
    if (F.vcu < 192) {
        for (int i = tid; i < 4096; i += NWAVES * 64) cs[i] = siluf(c[i]);
        __syncthreads();
        for (int cb = F.vcu; cb < 192; cb += F.G) {
            const int gc = cb * 64 + lane, li = gc / 6144, n = gc % 6144;
            const float* w = ada_w + (size_t)li * 1024 * 6144 + n;
            float a0 = 0.f, a1 = 0.f, a2 = 0.f, a3 = 0.f;
            const int k0 = F.wave * 128;
#pragma unroll 8
            for (int k = k0; k < k0 + 128; ++k) { const float wv = w[(size_t)k * 6144]; a0 += cs[k] * wv; a1 += cs[1024 + k] * wv; a2 += cs[2048 + k] * wv; a3 += cs[3072 + k] * wv; }
            red[(F.wave * 4 + 0) * 64 + lane] = a0; red[(F.wave * 4 + 1) * 64 + lane] = a1; red[(F.wave * 4 + 2) * 64 + lane] = a2; red[(F.wave * 4 + 3) * 64 + lane] = a3;
            __syncthreads();
            if (tid < 256) { const int b = tid >> 6, l = tid & 63; float s = 0.f;
#pragma unroll
                for (int w8 = 0; w8 < 8; ++w8) s += red[(w8 * 4 + b) * 64 + l];
                const int gc2 = cb * 64 + l, li2 = gc2 / 6144, n2 = gc2 % 6144;
                MOD[(size_t)(li2 * 4 + b) * 6144 + n2] = s + ada_b[(size_t)li2 * 6144 + n2]; }
            __syncthreads();
        }
    }
    LAS float* scr = (LAS float*)(F.lds + 32768 + F.wave * 8704);
    const int gw = F.vcu * NWAVES + F.wave, NGW = F.G * NWAVES;
    for (int it = gw; it < 161 * 16; it += NGW) cvt_win_item(w_in, F.ws, it / 161, it % 161, scr, lane);
}

__device__ __forceinline__ void p1_phase(Frame& F, const float* x, const float* g, const float* dt_bias) {
    const float* MOD = (const float*)(F.ws + WS_MOD);
    bf16* H = (bf16*)(F.ws + WS_H); float* DT = (float*)(F.ws + WS_DT); const bf16* WDT = (const bf16*)(F.ws + WS_WDT);
    constexpr int HRS = 2064;
    const int lane = lane_id(), tid = F.wave * 64 + lane;
    for (int rg = F.vcu; rg < T / 64; rg += F.G) {
#pragma unroll 1
        for (int i = 0; i < 8; ++i) {
            const int rl = F.wave * 8 + i, m = rg * 64 + rl, b = m >> 12; unsigned pk[4][2];
            adaln_row(x + (size_t)m * D, g, MOD + (size_t)b * 6144 + 1024, MOD + (size_t)b * 6144 + 0, lane, pk);
            GAS v2u* o8 = (GAS v2u*)(H + (size_t)m * D) + lane;
#pragma unroll
            for (int j = 0; j < 4; ++j) { o8[64 * j] = (v2u){pk[j][0], pk[j][1]}; *(LAS v2u*)(F.lds + rl * HRS + (4 * lane + 256 * j) * 2) = (v2u){pk[j][0], pk[j][1]}; }
        }
        __syncthreads();
        const int mt = F.wave & 1, kq = F.wave >> 1, r32 = lane & 31, hh = lane >> 5;
        f32x16 acc = {};
        const LAS unsigned char* ap = F.lds + (32 * mt + r32) * HRS + (256 * kq + 8 * hh) * 2;
        const bf16* bp = WDT + (size_t)r32 * 1024 + 256 * kq + 8 * hh;
#pragma unroll 4
        for (int s = 0; s < 16; ++s) { const bf16x8 a = *(const LAS bf16x8*)(ap + 32 * s); const bf16x8 bb = *(const GAS bf16x8*)(bp + 16 * s); acc = __builtin_amdgcn_mfma_f32_32x32x16_bf16(a, bb, acc, 0, 0, 0); }
        __syncthreads();
        LAS float* red = (LAS float*)F.lds;
#pragma unroll
        for (int r = 0; r < 16; ++r) red[((kq * 2 + mt) * 32 + rowidx(r, hh)) * 32 + r32] = acc[r];
        __syncthreads();
#pragma unroll
        for (int i = 0; i < 4; ++i) { const int o = tid + 512 * i, row = o >> 5, col = o & 31; float s = 0.f;
#pragma unroll
            for (int q = 0; q < 4; ++q) s += red[((q * 2 + (row >> 5)) * 32 + (row & 31)) * 32 + col];
            const float v = s + dt_bias[col];
            const float sp = fmaxf(v, 0.f) + log1pf(__expf(-fabsf(v)));
            DT[(size_t)(rg * 64 + row) * 32 + col] = sp; }
        __syncthreads();
    }
}

__device__ __forceinline__ f32x16 mma_lds(f32x16 acc, const LAS unsigned char* A, const LAS unsigned char* B, int ksteps, int lane) {
    const int r = lane & 31, hh = lane >> 5;
    const LAS unsigned char* pa = A + r * 272 + hh * 16; const LAS unsigned char* pb = B + r * 272 + hh * 16;
    for (int s = 0; s < ksteps; ++s) { const bf16x8 a = *(const LAS bf16x8*)(pa + 32 * s); const bf16x8 bb = *(const LAS bf16x8*)(pb + 32 * s); acc = __builtin_amdgcn_mfma_f32_32x32x16_bf16(a, bb, acc, 0, 0, 0); }
    return acc;
}
template <int NTOK> __device__ __forceinline__ void conv8(const bf16* XBC, int b, int tfirst, int col, const float* conv_w, const float* conv_b, float (&val)[NTOK][8]) {
    f32x4 w[4][2];
#pragma unroll
    for (int k = 0; k < 4; ++k) { w[k][0] = *(const GAS f32x4*)(conv_w + (size_t)k * CONVD + col); w[k][1] = *(const GAS f32x4*)(conv_w + (size_t)k * CONVD + col + 4); }
    const f32x4 b0 = *(const GAS f32x4*)(conv_b + col), b1 = *(const GAS f32x4*)(conv_b + col + 4);
    v4u raw[NTOK + 3];
#pragma unroll
    for (int i = 0; i < NTOK + 3; ++i) { const int t = tfirst - 3 + i;
        raw[i] = (t >= 0) ? *(const GAS v4u*)(XBC + ((size_t)b * SEQ + t) * CONVD + col) : (v4u){0u, 0u, 0u, 0u}; }
#pragma unroll
    for (int o = 0; o < NTOK; ++o) {
        float a[8] = {b0.x, b0.y, b0.z, b0.w, b1.x, b1.y, b1.z, b1.w};
#pragma unroll
        for (int k = 0; k < 4; ++k) { const v4u rw = raw[o + k];
            a[0] += w[k][0].x * bflo(rw.x); a[1] += w[k][0].y * bfhi(rw.x); a[2] += w[k][0].z * bflo(rw.y); a[3] += w[k][0].w * bfhi(rw.y);
            a[4] += w[k][1].x * bflo(rw.z); a[5] += w[k][1].y * bfhi(rw.z); a[6] += w[k][1].z * bflo(rw.w); a[7] += w[k][1].w * bfhi(rw.w); }
#pragma unroll
        for (int j = 0; j < 8; ++j) val[o][j] = siluf(a[j]);
    }
}
__device__ __forceinline__ void bc_conv_prepass(Frame& F, const float* conv_w, const float* conv_b) {
    bf16* XBC = (bf16*)(F.ws + WS_BIG); const bf16* HALO = (const bf16*)(F.ws + WS_HALO);
    const int lane = lane_id(), run = F.wave;
    for (int it = F.vcu; it < 256; it += F.G) {
        const int chunk = it >> 1, half = it & 1, col = 2048 + half * 512 + 8 * lane;
        f32x4 w[4][2];
#pragma unroll
        for (int k = 0; k < 4; ++k) { w[k][0] = *(const GAS f32x4*)(conv_w + (size_t)k * CONVD + col); w[k][1] = *(const GAS f32x4*)(conv_w + (size_t)k * CONVD + col + 4); }
        const f32x4 b0 = *(const GAS f32x4*)(conv_b + col), b1 = *(const GAS f32x4*)(conv_b + col + 4);
        v4u raw[19];
#pragma unroll
        for (int i = 0; i < 19; ++i) { const int tt = 16 * run - 3 + i;
            if (tt >= 0) raw[i] = *(const GAS v4u*)(XBC + ((size_t)chunk * 128 + tt) * CONVD + col);
            else raw[i] = (chunk & 31) ? *(const GAS v4u*)(HALO + ((size_t)(chunk - 1) * 3 + (tt + 3)) * 1024 + (col - 2048)) : (v4u){0u, 0u, 0u, 0u}; }
        asm volatile("s_waitcnt vmcnt(0)" ::: "memory");
        __syncthreads();
#pragma unroll
        for (int o = 0; o < 16; ++o) {
            float a[8] = {b0.x, b0.y, b0.z, b0.w, b1.x, b1.y, b1.z, b1.w};
#pragma unroll
            for (int k = 0; k < 4; ++k) { const v4u rw = raw[o + k];
                a[0] += w[k][0].x * bflo(rw.x); a[1] += w[k][0].y * bfhi(rw.x); a[2] += w[k][0].z * bflo(rw.y); a[3] += w[k][0].w * bfhi(rw.y);
                a[4] += w[k][1].x * bflo(rw.z); a[5] += w[k][1].y * bfhi(rw.z); a[6] += w[k][1].z * bflo(rw.w); a[7] += w[k][1].w * bfhi(rw.w); }
            *(GAS v4u*)(XBC + ((size_t)chunk * 128 + 16 * run + o) * CONVD + col) = (v4u){pk2(siluf(a[0]), siluf(a[1])), pk2(siluf(a[2]), siluf(a[3])), pk2(siluf(a[4]), siluf(a[5])), pk2(siluf(a[6]), siluf(a[7]))};
        }
    }
}

constexpr int SO_CS = 0, SO_BS = 34816, SO_BDT = 69632, SO_XT = 104448, SO_HT = 121856, SO_XS = 139264, SO_TAB = 157696;
__device__ __forceinline__ void ssd_chain(Frame& F, int b, int h, const float* conv_w, const float* conv_b, const float* a_log, const float* d_skip) {
    const int g = h >> 3, lane = lane_id(), wave = F.wave, tid = wave * 64 + lane, r32 = lane & 31, hh = lane >> 5;
    LAS unsigned char* L = F.lds;
    const bf16* XBC = (const bf16*)(F.ws + WS_BIG); const bf16* Z = (const bf16*)F.out; const float* DT = (const float*)(F.ws + WS_DT);
    bf16* YA = (bf16*)(F.ws + WS_YA); float* PSSQ = (float*)(F.ws + WS_PSSQ);
    const float A_h = -__expf(a_log[h]), D_h = d_skip[h];
    const int bc_chunk = tid & 15, bc_s0 = 4 * (tid >> 4);
    const int x_chunk = tid & 7, x_s0 = 2 * (tid >> 3);
    const int e_l = tid >> 2, e_pc = tid & 3, e_p0 = 16 * e_pc;
    const int xcol = h * 64 + 8 * x_chunk;
    const bf16* pB = XBC + ((size_t)b * SEQ + bc_s0) * CONVD + 2048 + g * 128 + 8 * bc_chunk;
    const bf16* pX = XBC + ((size_t)b * SEQ + x_s0) * CONVD + xcol;
    const bf16* pZ = Z + ((size_t)b * SEQ + e_l) * DI + h * 64 + e_p0;
    const float* pDT = DT + ((size_t)b * SEQ + 2 * lane) * 32 + h;
    v4u bq[4], cq[4], xr[5]; float dn0 = 0.f, dn1 = 0.f;
#define SSD_LOADS(cc) do { const int t0_ = (cc) * CHUNK; \
        _Pragma("unroll") for (int o = 0; o < 4; ++o) { bq[o] = *(const GAS v4u*)(pB + (size_t)(t0_ + o) * CONVD); cq[o] = *(const GAS v4u*)(pB + (size_t)(t0_ + o) * CONVD + 512); } \
        _Pragma("unroll") for (int i = 0; i < 5; ++i) { const int tr_ = t0_ + x_s0 - 3 + i; xr[i] = (tr_ >= 0) ? *(const GAS v4u*)(pX + (ptrdiff_t)(t0_ - 3 + i) * CONVD) : (v4u){0u, 0u, 0u, 0u}; } \
        if (wave == 0) { dn0 = pDT[(size_t)t0_ * 32]; dn1 = pDT[(size_t)t0_ * 32 + 32]; } } while (0)
#define SSD_TABLES(tabp) do { if (wave == 0) { LAS float* acs_ = (tabp); const float a0 = dn0 * A_h, a1 = dn1 * A_h, sp_ = a0 + a1; float incl = sp_; \
        _Pragma("unroll") for (int o = 1; o < 64; o <<= 1) { const float t_ = __shfl_up(incl, o); if (lane >= o) incl += t_; } \
        const float c0 = incl - sp_ + a0, c1 = incl, tot = __shfl(incl, 63); \
        acs_[2 * lane] = c0; acs_[2 * lane + 1] = c1; acs_[128 + 2 * lane] = dn0; acs_[128 + 2 * lane + 1] = dn1; \
        acs_[256 + 2 * lane] = __expf(c0); acs_[256 + 2 * lane + 1] = __expf(c1); acs_[384 + 2 * lane] = __expf(tot - c0); acs_[384 + 2 * lane + 1] = __expf(tot - c1); } } while (0)
    SSD_LOADS(0);
    SSD_TABLES((LAS float*)(L + SO_TAB));
    f32x16 Hst = {};
    __syncthreads();
#pragma unroll 1
    for (int c = 0; c < NCHUNK; ++c) {
        const int t0 = c * CHUNK; const size_t rowbase = (size_t)b * SEQ + t0;
        LAS float* acs = (LAS float*)(L + SO_TAB + (c & 1) * 2048); LAS float* dtv = acs + 128; LAS float* eacs = acs + 256; LAS float* dend = acs + 384;
        const v4u zz0 = *(const GAS v4u*)(pZ + (size_t)t0 * DI), zz1 = *(const GAS v4u*)(pZ + (size_t)t0 * DI + 8);
        f32x4 xw[4][2];
#pragma unroll
        for (int k = 0; k < 4; ++k) { xw[k][0] = *(const GAS f32x4*)(conv_w + (size_t)k * CONVD + xcol); xw[k][1] = *(const GAS f32x4*)(conv_w + (size_t)k * CONVD + xcol + 4); }
        const f32x4 xb0 = *(const GAS f32x4*)(conv_b + xcol), xb1 = *(const GAS f32x4*)(conv_b + xcol + 4);
        {   const f32x4 de = *(const LAS f32x4*)(dend + bc_s0);
#pragma unroll
            for (int o = 0; o < 4; ++o) { *(LAS v4u*)(L + SO_CS + (bc_s0 + o) * 272 + bc_chunk * 16) = cq[o]; *(LAS v4u*)(L + SO_BS + (bc_s0 + o) * 272 + bc_chunk * 16) = bq[o]; }
            const unsigned bw[4][4] = {{bq[0].x, bq[0].y, bq[0].z, bq[0].w}, {bq[1].x, bq[1].y, bq[1].z, bq[1].w}, {bq[2].x, bq[2].y, bq[2].z, bq[2].w}, {bq[3].x, bq[3].y, bq[3].z, bq[3].w}};
#pragma unroll
            for (int jw = 0; jw < 4; ++jw) {
                *(LAS v2u*)(L + SO_BDT + (8 * bc_chunk + 2 * jw) * 272 + bc_s0 * 2) = (v2u){pk2(bflo(bw[0][jw]) * de.x, bflo(bw[1][jw]) * de.y), pk2(bflo(bw[2][jw]) * de.z, bflo(bw[3][jw]) * de.w)};
                *(LAS v2u*)(L + SO_BDT + (8 * bc_chunk + 2 * jw + 1) * 272 + bc_s0 * 2) = (v2u){pk2(bfhi(bw[0][jw]) * de.x, bfhi(bw[1][jw]) * de.y), pk2(bfhi(bw[2][jw]) * de.z, bfhi(bw[3][jw]) * de.w)}; }
        }
        __syncthreads();
        const int st = wave >> 1, lt0 = 2 * (wave & 1);
        f32x16 cb0 = {}, cb1 = {};
        cb0 = mma_lds(cb0, L + SO_BS + 32 * st * 272, L + SO_CS + 32 * lt0 * 272, 8, lane);
        cb1 = mma_lds(cb1, L + SO_BS + 32 * st * 272, L + SO_CS + 32 * (lt0 + 1) * 272, 8, lane);
        __syncthreads();
#pragma unroll
        for (int i = 0; i < 2; ++i) { const int l_ = 32 * (lt0 + i) + r32; const float el = acs[l_];
#pragma unroll
            for (int q = 0; q < 4; ++q) { const int sb = 32 * st + 8 * q + 4 * hh; const f32x4 as4 = *(const LAS f32x4*)(acs + sb); float mv[4];
#pragma unroll
                for (int jj = 0; jj < 4; ++jj) { const float cv = (i == 0) ? cb0[4 * q + jj] : cb1[4 * q + jj]; mv[jj] = (l_ >= sb + jj) ? cv * __expf(fminf(el - as4[jj], 0.f)) : 0.f; }
                *(LAS v2u*)(L + SO_BS + l_ * 272 + sb * 2) = (v2u){pk2(mv[0], mv[1]), pk2(mv[2], mv[3])}; } }
        {
            const int nt = wave >> 1, pt = wave & 1, p_ = 32 * pt + r32;
#pragma unroll
            for (int q = 0; q < 4; ++q) { const int nb = 32 * nt + 8 * q + 4 * hh;
                *(LAS v2u*)(L + SO_HT + p_ * 272 + nb * 2) = (v2u){pk2(Hst[4 * q], Hst[4 * q + 1]), pk2(Hst[4 * q + 2], Hst[4 * q + 3])}; } }
        {   float val[2][8];
#pragma unroll
            for (int o = 0; o < 2; ++o) {
                float a[8] = {xb0.x, xb0.y, xb0.z, xb0.w, xb1.x, xb1.y, xb1.z, xb1.w};
#pragma unroll
                for (int k = 0; k < 4; ++k) { const v4u rw = xr[o + k];
                    a[0] += xw[k][0].x * bflo(rw.x); a[1] += xw[k][0].y * bfhi(rw.x); a[2] += xw[k][0].z * bflo(rw.y); a[3] += xw[k][0].w * bfhi(rw.y);
                    a[4] += xw[k][1].x * bflo(rw.z); a[5] += xw[k][1].y * bfhi(rw.z); a[6] += xw[k][1].z * bflo(rw.w); a[7] += xw[k][1].w * bfhi(rw.w); }
#pragma unroll
                for (int j = 0; j < 8; ++j) val[o][j] = siluf(a[j]);
                *(LAS v4u*)(L + SO_XS + (x_s0 + o) * 144 + x_chunk * 16) = (v4u){pk2(val[o][0], val[o][1]), pk2(val[o][2], val[o][3]), pk2(val[o][4], val[o][5]), pk2(val[o][6], val[o][7])};
            }
            const float d0 = dtv[x_s0], d1 = dtv[x_s0 + 1];
#pragma unroll
            for (int j = 0; j < 8; ++j) *(LAS unsigned*)(L + SO_XT + (8 * x_chunk + j) * 272 + x_s0 * 2) = pk2(val[0][j] * d0, val[1][j] * d1);
        }
        if (c + 1 < NCHUNK) SSD_LOADS(c + 1);
        __syncthreads();
        const int lt = wave >> 1, pt = wave & 1;
        f32x16 y = {};
        y = mma_lds(y, L + SO_CS + 32 * lt * 272, L + SO_HT + 32 * pt * 272, 8, lane);
#pragma unroll
        for (int q = 0; q < 4; ++q) { const f32x4 e4 = *(const LAS f32x4*)(eacs + 32 * lt + 8 * q + 4 * hh);
            y[4 * q] *= e4.x; y[4 * q + 1] *= e4.y; y[4 * q + 2] *= e4.z; y[4 * q + 3] *= e4.w; }
        y = mma_lds(y, L + SO_BS + 32 * lt * 272, L + SO_XT + 32 * pt * 272, 2 * (lt + 1), lane);
        {   const float etot = eacs[127];
#pragma unroll
            for (int r = 0; r < 16; ++r) Hst[r] *= etot;
            Hst = mma_lds(Hst, L + SO_BDT + 32 * lt * 272, L + SO_XT + 32 * pt * 272, 8, lane); }
        if (c + 1 < NCHUNK) SSD_TABLES((LAS float*)(L + SO_TAB + ((c + 1) & 1) * 2048));
        __syncthreads();
#pragma unroll
        for (int r = 0; r < 16; ++r) *(LAS float*)(L + SO_CS + (32 * lt + rowidx(r, hh)) * 272 + (32 * pt + r32) * 4) = y[r];
        __syncthreads();
        {   const size_t row = rowbase + e_l;
            const v4u xx0 = *(const LAS v4u*)(L + SO_XS + e_l * 144 + e_p0 * 2), xx1 = *(const LAS v4u*)(L + SO_XS + e_l * 144 + e_p0 * 2 + 16);
            float yv[16], xv[16], zv[16];
#pragma unroll
            for (int i = 0; i < 4; ++i) { const f32x4 t = *(const LAS f32x4*)(L + SO_CS + e_l * 272 + (e_p0 + 4 * i) * 4); yv[4 * i] = t.x; yv[4 * i + 1] = t.y; yv[4 * i + 2] = t.z; yv[4 * i + 3] = t.w; }
            const unsigned xw_[8] = {xx0.x, xx0.y, xx0.z, xx0.w, xx1.x, xx1.y, xx1.z, xx1.w}, zw[8] = {zz0.x, zz0.y, zz0.z, zz0.w, zz1.x, zz1.y, zz1.z, zz1.w};
#pragma unroll
            for (int i = 0; i < 8; ++i) { xv[2 * i] = bflo(xw_[i]); xv[2 * i + 1] = bfhi(xw_[i]); zv[2 * i] = bflo(zw[i]); zv[2 * i + 1] = bfhi(zw[i]); }
            float gv[16], ss = 0.f;
#pragma unroll
            for (int i = 0; i < 16; ++i) { gv[i] = (yv[i] + D_h * xv[i]) * siluf(zv[i]); ss += gv[i] * gv[i]; }
            bf16* yo = YA + row * 3072 + h * 64 + e_p0;
            *(GAS v4u*)yo = (v4u){pk2(gv[0], gv[1]), pk2(gv[2], gv[3]), pk2(gv[4], gv[5]), pk2(gv[6], gv[7])};
            *(GAS v4u*)(yo + 8) = (v4u){pk2(gv[8], gv[9]), pk2(gv[10], gv[11]), pk2(gv[12], gv[13]), pk2(gv[14], gv[15])};
            ss += __shfl_xor(ss, 1); ss += __shfl_xor(ss, 2);
            if (e_pc == 0) PSSQ[row * 32 + h] = ss;
        }
        __syncthreads();
    }
#undef SSD_LOADS
#undef SSD_TABLES
}

__device__ __forceinline__ s16x4 vtr(const LAS unsigned char* p) { typedef short v4i16_t __attribute__((ext_vector_type(4))); return __builtin_bit_cast(s16x4, __builtin_amdgcn_ds_read_tr16_b64_v4i16((LAS v4i16_t*)p)); }
constexpr int AO_BIAS = 0, AO_VST = 2048, VST_BYTES = 4608;
__device__ __forceinline__ void attn_wave_tile(Frame& F, int b, int h, int gi, int res, int m0, bf16* Q, const bf16* Kt, const bf16* Vt, float* LSE) {
    const int lane = lane_id(), r32 = lane & 31, hh = lane >> 5;
    const int dsh = 2 * gi;
    const LAS float* biasv = (const LAS float*)(F.lds + AO_BIAS) + gi * 132;
    LAS unsigned char* vst = F.lds + AO_VST + F.wave * VST_BYTES;
    const size_t qrow = (size_t)b * SEQ + ((size_t)(m0 + r32) << dsh) + res;
    const bf16* qp = Q + qrow * QW + gi * 1024 + h * 64 + hh * 8;
    bf16x8 qf[4];
#pragma unroll
    for (int s = 0; s < 4; ++s) qf[s] = *(const GAS bf16x8*)(qp + 16 * s);
    f32x16 sc[5];
#pragma unroll
    for (int kb = 0; kb < 5; ++kb) {
        int kpos = m0 - 128 + 32 * kb + r32; kpos = kpos < 0 ? 0 : kpos;
        const bf16* kp = Kt + ((size_t)b * SEQ + ((size_t)kpos << dsh) + res) * D + h * 64 + hh * 8;
        f32x16 acc = {};
#pragma unroll
        for (int s = 0; s < 4; ++s) { const bf16x8 kf = *(const GAS bf16x8*)(kp + 16 * s); acc = __builtin_amdgcn_mfma_f32_32x32x16_bf16(kf, qf[s], acc, 0, 0, 0); }
        sc[kb] = acc;
    }
    float mx = -INFINITY;
#pragma unroll
    for (int kb = 0; kb < 5; ++kb)
#pragma unroll
        for (int r = 0; r < 16; ++r) { const int ki = rowidx(r, hh), kpos = m0 - 128 + 32 * kb + ki, delta = r32 + 128 - 32 * kb - ki;
            const bool valid = (delta >= 0) && (delta <= 128) && (kpos >= 0);
            const int dc = delta < 0 ? 0 : (delta > 128 ? 128 : delta);
            const float v = valid ? sc[kb][r] * 0.125f + biasv[dc] : -INFINITY;
            sc[kb][r] = v; mx = fmaxf(mx, v); }
    mx = fmaxf(mx, __shfl_xor(mx, 32));
    float lsum = 0.f;
#pragma unroll
    for (int kb = 0; kb < 5; ++kb)
#pragma unroll
        for (int r = 0; r < 16; ++r) { const float p = fexp(sc[kb][r] - mx); sc[kb][r] = p; lsum += p; }
    lsum += __shfl_xor(lsum, 32);
    f32x16 o0 = {}, o1 = {};
    const int g4 = lane >> 4, q_ = (lane & 15) >> 2, p_ = lane & 3;
    const LAS unsigned char* trb = vst + (4 * (g4 >> 1) + q_) * 144 + (16 * (g4 & 1) + 4 * p_) * 2;
#pragma unroll
    for (int kb = 0; kb < 5; ++kb) {
#pragma unroll
        for (int i = 0; i < 4; ++i) { const int cc = lane + 64 * i, key = cc >> 3, dc = cc & 7; int kpos = m0 - 128 + 32 * kb + key; kpos = kpos < 0 ? 0 : kpos;
            const v4u v = *(const GAS v4u*)(Vt + ((size_t)b * SEQ + ((size_t)kpos << dsh) + res) * D + h * 64 + 8 * dc);
            *(LAS v4u*)(vst + key * 144 + dc * 16) = v; }
        asm volatile("" ::: "memory");
#pragma unroll
        for (int s = 0; s < 2; ++s) {
            const f32x16& P = sc[kb];
            v4u pw = (v4u){pk2(P[8 * s], P[8 * s + 1]), pk2(P[8 * s + 2], P[8 * s + 3]), pk2(P[8 * s + 4], P[8 * s + 5]), pk2(P[8 * s + 6], P[8 * s + 7])};
            const bf16x8 pa = __builtin_bit_cast(bf16x8, pw);
#pragma unroll
            for (int db = 0; db < 2; ++db) {
                const s16x4 lo = vtr(trb + (16 * s) * 144 + db * 64), hi = vtr(trb + (16 * s + 8) * 144 + db * 64);
                const bf16x8 vb = (bf16x8){lo[0], lo[1], lo[2], lo[3], hi[0], hi[1], hi[2], hi[3]};
                if (db == 0) o0 = __builtin_amdgcn_mfma_f32_32x32x16_bf16(pa, vb, o0, 0, 0, 0); else o1 = __builtin_amdgcn_mfma_f32_32x32x16_bf16(pa, vb, o1, 0, 0, 0);
            }
        }
    }
    const float linv = 1.0f / lsum;
#pragma unroll
    for (int r = 0; r < 16; ++r) { const int q = rowidx(r, hh); const float li = __shfl(linv, q);
        *(LAS bf16*)(vst + q * 144 + r32 * 2) = (bf16)f2bf(o0[r] * li); *(LAS bf16*)(vst + q * 144 + (32 + r32) * 2) = (bf16)f2bf(o1[r] * li); }
    asm volatile("s_waitcnt lgkmcnt(0)" ::: "memory");
#pragma unroll
    for (int i = 0; i < 4; ++i) { const int cc = lane + 64 * i, q = cc >> 3, dc = cc & 7; const v4u v = *(const LAS v4u*)(vst + q * 144 + dc * 16);
        *(GAS v4u*)(Q + ((size_t)b * SEQ + ((size_t)(m0 + q) << dsh) + res) * QW + gi * 1024 + h * 64 + 8 * dc) = v; }
    if (lane < 32) LSE[qrow * 48 + gi * 16 + h] = mx + __logf(lsum);
    asm volatile("s_waitcnt lgkmcnt(0)" ::: "memory");
}
__device__ __forceinline__ void attn_unit(Frame& F, int u, const float* rel_table) {
    const int b = u >> 6, h = (u >> 2) & 15, span = u & 3;
    bf16* Q = (bf16*)(F.ws + WS_BIG); const bf16* Kt = (const bf16*)F.out; const bf16* Vt = Kt + (size_t)T * D;
    float* LSE = (float*)(F.ws + WS_LSE); bf16* YA = (bf16*)(F.ws + WS_YA);
    const int tid = F.wave * 64 + lane_id();
    __syncthreads();
    for (int i = tid; i < 3 * 132; i += NWAVES * 64) { const int gi = i / 132, dl = i % 132; ((LAS float*)(F.lds + AO_BIAS))[i] = dl <= 128 ? rel_table[(int)T5_BUCKET[gi][dl] * 48 + gi * 16 + h] : 0.f; }
    __syncthreads();
#pragma unroll 1
    for (int i = 0; i < 12; ++i) {
        const int wt = F.wave + 8 * i, gi = wt >> 5, idx = wt & 31;
        const int nbk = 32 >> (2 * gi), res = idx / nbk, blk = idx % nbk, Ls = 1024 >> (2 * gi);
        attn_wave_tile(F, b, h, gi, res, span * Ls + 32 * blk, Q, Kt, Vt, LSE);
    }
    VM_WAIT();
    __syncthreads();
#pragma unroll 1
    for (int i = 0; i < 16; ++i) { const int it = tid + 512 * i, tok = it >> 3, dc = it & 7; const size_t row = (size_t)b * SEQ + span * 1024 + tok;
        const float l0 = LSE[row * 48 + h], l1 = LSE[row * 48 + 16 + h], l2 = LSE[row * 48 + 32 + h];
        const float mm = fmaxf(l0, fmaxf(l1, l2)); float w0 = __expf(l0 - mm), w1 = __expf(l1 - mm), w2 = __expf(l2 - mm); const float inv = 1.0f / (w0 + w1 + w2); w0 *= inv; w1 *= inv; w2 *= inv;
        const bf16* op = Q + row * QW + h * 64 + 8 * dc;
        const v4u a = *(const GAS v4u*)op, bq = *(const GAS v4u*)(op + 1024), cq = *(const GAS v4u*)(op + 2048);
        const unsigned aw[4] = {a.x, a.y, a.z, a.w}, bw[4] = {bq.x, bq.y, bq.z, bq.w}, cw[4] = {cq.x, cq.y, cq.z, cq.w}; unsigned ow[4];
#pragma unroll
        for (int j = 0; j < 4; ++j) ow[j] = pk2(w0 * bflo(aw[j]) + w1 * bflo(bw[j]) + w2 * bflo(cw[j]), w0 * bfhi(aw[j]) + w1 * bfhi(bw[j]) + w2 * bfhi(cw[j]));
        *(GAS v4u*)(YA + row * 3072 + 2048 + h * 64 + 8 * dc) = (v4u){ow[0], ow[1], ow[2], ow[3]}; }
}
__device__ __forceinline__ void ynorm_phase(Frame& F, const float* norm_g) {
    bf16* YA = (bf16*)(F.ws + WS_YA); const float* PSSQ = (const float*)(F.ws + WS_PSSQ);
    const int gw = F.vcu * NWAVES + F.wave, NGW = F.G * NWAVES, lane = lane_id();
    for (int m = gw; m < T; m += NGW) {
        const float ps = lane < 32 ? PSSQ[(size_t)m * 32 + lane] : 0.f;
        const float rstd = frsq(wave_sum(ps) * (1.0f / DI) + EPS);
#pragma unroll
        for (int j = 0; j < 4; ++j) { const int k = 8 * lane + 512 * j; bf16* p = YA + (size_t)m * 3072 + k;
            const v4u v = *(const GAS v4u*)p; const f32x4 g0 = *(const GAS f32x4*)(norm_g + k), g1 = *(const GAS f32x4*)(norm_g + k + 4);
            *(GAS v4u*)p = (v4u){pk2(bflo(v.x) * rstd * g0.x, bfhi(v.x) * rstd * g0.y), pk2(bflo(v.y) * rstd * g0.z, bfhi(v.y) * rstd * g0.w),
                                 pk2(bflo(v.z) * rstd * g1.x, bfhi(v.z) * rstd * g1.y), pk2(bflo(v.w) * rstd * g1.z, bfhi(v.w) * rstd * g1.w)}; }
    }
}

__device__ __forceinline__ void dwconv_phase(Frame& F, const float* w_dw, const float* b_dw, const float* ln_g, const float* ln_b) {
    const bf16* U = (const bf16*)(F.ws + WS_U); bf16* V2 = (bf16*)(F.ws + WS_V2);
    const int lane = lane_id(), tid = F.wave * 64 + lane;
    const int c0 = 2 * tid;
    float w0[31], w1[31];
#pragma unroll
    for (int k = 0; k < 31; ++k) { const float2 t = *(const float2*)(w_dw + (size_t)k * D + c0); w0[k] = t.x; w1[k] = t.y; }
    const float2 bb = *(const float2*)(b_dw + c0), lg = *(const float2*)(ln_g + c0), lb = *(const float2*)(ln_b + c0);
    LAS float* red = (LAS float*)F.lds;
    LAS float* tot = red + 256;
    const int sidx = (int)(__builtin_bitreverse32((unsigned)(lane & 31)) >> 27);
#pragma unroll 1
    for (int u = F.vcu; u < T / 16; u += F.G) {
        const int trow = u * 16, tb = trow & (SEQ - 1);
        float a0[16], a1[16];
#pragma unroll
        for (int o = 0; o < 16; ++o) { a0[o] = bb.x; a1[o] = bb.y; }
#pragma unroll
        for (int r = 0; r < 46; ++r) {
            unsigned raw = 0u;
            if (tb - 30 + r >= 0) raw = *(const GAS unsigned*)(U + (size_t)(trow - 30 + r) * D + c0);
            const float v0 = bflo(raw), v1 = bfhi(raw);
#pragma unroll
            for (int o = 0; o < 16; ++o) { const int k = r - o; if (k >= 0 && k <= 30) { a0[o] += w0[k] * v0; a1[o] += w1[k] * v1; } }
        }
        float v[32];
#pragma unroll
        for (int o = 0; o < 16; ++o) { v[o] = a0[o] + a1[o]; v[16 + o] = a0[o] * a0[o] + a1[o] * a1[o]; }
#define DW_STEP(k, half) { const bool up = (lane >> (k)) & 1; \
            _Pragma("unroll") for (int i = 0; i < (half); ++i) { const float send = up ? v[i] : v[i + (half)], keep = up ? v[i + (half)] : v[i]; v[i] = keep + swz_xor<(1 << (k))>(send); } }
        DW_STEP(0, 16) DW_STEP(1, 8) DW_STEP(2, 4) DW_STEP(3, 2) DW_STEP(4, 1)
#undef DW_STEP
        const float tv = v[0] + __shfl_xor(v[0], 32);
        __syncthreads();
        if (lane < 32) red[F.wave * 32 + sidx] = tv;
        __syncthreads();
        if (tid < 32) { float s = 0.f;
#pragma unroll
            for (int w8 = 0; w8 < 8; ++w8) s += red[w8 * 32 + tid];
            tot[tid] = s; }
        __syncthreads();
#pragma unroll
        for (int o = 0; o < 16; ++o) { const float mean = tot[o] * (1.0f / D), var = tot[16 + o] * (1.0f / D) - mean * mean; const float rstd = frsq(fmaxf(var, 0.f) + EPS);
            const float y0 = (a0[o] - mean) * rstd * lg.x + lb.x, y1 = (a1[o] - mean) * rstd * lg.y + lb.y;
            *(GAS unsigned*)(V2 + (size_t)(trow + o) * D + c0) = pk2(siluf(y0), siluf(y1)); }
    }
}

struct Args { const float* in[27]; float* out; unsigned char* ws; int ph_lo, ph_hi; };
__global__ void __launch_bounds__(NWAVES * 64, 2) mega_fwd(Args args) {
    extern __shared__ __attribute__((aligned(16))) unsigned char lds[];
    Frame F;
    F.lds = (LAS unsigned char*)lds;
    F.wave = __builtin_amdgcn_readfirstlane(threadIdx.x >> 6);
    F.G = gridDim.x; { const int bx = blockIdx.x; F.vcu = (F.G % 8 == 0) ? (bx % 8) * (F.G / 8) + bx / 8 : bx; }
    F.ws = args.ws; F.out = args.out; F.in = nullptr;
    volatile LAS unsigned* MISC = (volatile LAS unsigned*)(F.lds + MISC_OFF);
    if (threadIdx.x < 64) ((LAS unsigned*)(F.lds + MISC_OFF))[threadIdx.x] = 0u;
    __syncthreads();
    gu32* ctl = (gu32*)(F.ws + WS_CTL);
    XcdBarrier bar = xcd_barrier_post((unsigned*)(ctl + CW_BAR), MISC + 8, threadIdx.x == 0);
    const int lo = args.ph_lo, hi = args.ph_hi;
#define IN(k) (lo <= (k) && (k) < hi)
#ifdef PROBE_MASK
    unsigned long long pr_sum = 0ull, pr_t0 = 0ull;
#define PR_BEGIN(k) do { if ((PROBE_MASK >> (k)) & 1) pr_t0 = __builtin_amdgcn_s_memrealtime(); } while (0)
#define PR_END(k) do { if ((PROBE_MASK >> (k)) & 1) pr_sum += __builtin_amdgcn_s_memrealtime() - pr_t0; } while (0)
#else
#define PR_BEGIN(k) do {} while (0)
#define PR_END(k) do {} while (0)
#endif
#define SEAM(k) do { if (IN(k) && IN((k) + 1)) xcd_barrier(bar, F.wave); PR_END(k); PR_BEGIN((k) + 1); } while (0)
    PR_BEGIN(0);
    const float* x = args.in[0]; const float* MOD = (const float*)(F.ws + WS_MOD);
    const float* MOD0 = MOD; const float* MOD1 = MOD + 4 * 6144;
    LAS float* cscr = (LAS float*)(F.lds + F.wave * 8704);
    const int gw = F.vcu * NWAVES + F.wave, NGW = F.G * NWAVES;
    pg8::StaticOrder S;

    if (IN(0)) { p0_phase(F, args.in[1], args.in[2], args.in[3], args.in[6]); } SEAM(0);
    if (IN(1)) { p1_phase(F, x, args.in[4], args.in[9]); } SEAM(1);
    if (IN(2)) {
        pg8::Gemm g{(const bf16*)(F.ws + WS_H), (const bf16*)(F.ws + WS_WZX), T, 5120, D}; S.init(T, 5120, F.G, (int)blockIdx.x);
        pg8::EpiBf16Seg E{(bf16*)F.out, DI, 8, (bf16*)(F.ws + WS_BIG), CONVD, 1 << 30, nullptr, 0, (bf16*)(F.ws + WS_HALO)};
        pg8::gemm_phase<pg8::EpiBf16Seg, pg8::StaticOrder, true, true>(F.lds, F.wave, g, S, E);
    } SEAM(2);
    if (IN(3)) {
        bc_conv_prepass(F, args.in[7], args.in[8]);
        xcd_barrier(bar, F.wave);
        if ((F.vcu & 1) == 0) { for (int u = F.vcu >> 1; u < NB * NH; u += (F.G + 1) / 2) ssd_chain(F, u >> 5, u & 31, args.in[7], args.in[8], args.in[10], args.in[11]); }
        else { const int cw = (F.vcu >> 1) * NWAVES + F.wave, ncw = (F.G / 2) * NWAVES;
            for (int it = cw; it < 160 * 16; it += ncw) cvt_win_item(args.in[6], F.ws, it / 160, 161 + it % 160, cscr, lane_id()); }
    } SEAM(3);
    if (IN(4)) {
        pg8::Gemm g{(const bf16*)(F.ws + WS_H), (const bf16*)(F.ws + WS_WQKV), T, 5120, D}; S.init(T, 5120, F.G, (int)blockIdx.x);
        pg8::EpiBf16Seg E{(bf16*)(F.ws + WS_BIG), QW, 12, (bf16*)F.out, D, 16, (bf16*)F.out + (size_t)T * D, D, nullptr};
        pg8::gemm_phase<pg8::EpiBf16Seg, pg8::StaticOrder, true, true>(F.lds, F.wave, g, S, E);
    } SEAM(4);
    if (IN(5)) {
        for (int u = F.vcu; u < 256; u += F.G) attn_unit(F, u, args.in[14]);
        ynorm_phase(F, args.in[12]);
        __syncthreads();
        constexpr int I_OUT = 48 * 32, I_GU = 16 * 88, I_DN = 44 * 32, I_C1 = 16 * 32, I_C2 = 16 * 32;
        constexpr int NIT = I_OUT + 2 * (2 * I_GU + I_DN) + 2 * I_C1 + I_C2;
        const float* wg = args.in[23]; const float* wu = args.in[24]; const float* wd = args.in[25];
        for (int it = gw; it < NIT; it += NGW) { int r = it;
            if (r < I_OUT) { cvt_plain_item(args.in[13], 3072, D, (bf16*)(F.ws + WS_WOUT), r, cscr, lane_id()); continue; } r -= I_OUT;
            if (r < I_GU) { cvt_pair_item(wg, D, FH, 0, FH, 0, (bf16*)(F.ws + WS_WGU0), r, cscr, lane_id()); continue; } r -= I_GU;
            if (r < I_GU) { cvt_pair_item(wu, D, FH, 0, FH, 1, (bf16*)(F.ws + WS_WGU0), r, cscr, lane_id()); continue; } r -= I_GU;
            if (r < I_DN) { cvt_plain_item(wd, FH, D, (bf16*)(F.ws + WS_WD0), r, cscr, lane_id()); continue; } r -= I_DN;
            if (r < I_GU) { cvt_pair_item(wg + (size_t)D * FH, D, FH, 0, FH, 0, (bf16*)(F.ws + WS_WGU1), r, cscr, lane_id()); continue; } r -= I_GU;
            if (r < I_GU) { cvt_pair_item(wu + (size_t)D * FH, D, FH, 0, FH, 1, (bf16*)(F.ws + WS_WGU1), r, cscr, lane_id()); continue; } r -= I_GU;
            if (r < I_DN) { cvt_plain_item(wd + (size_t)FH * D, FH, D, (bf16*)(F.ws + WS_WD1), r, cscr, lane_id()); continue; } r -= I_DN;
            if (r < I_C1) { cvt_pair_item(args.in[15], D, 2048, 0, 1024, 0, (bf16*)(F.ws + WS_WC1), r, cscr, lane_id()); continue; } r -= I_C1;
            if (r < I_C1) { cvt_pair_item(args.in[15], D, 2048, 1024, 1024, 1, (bf16*)(F.ws + WS_WC1), r, cscr, lane_id()); continue; } r -= I_C1;
            cvt_plain_item(args.in[21], D, D, (bf16*)(F.ws + WS_WC2), r, cscr, lane_id());
        }
    } SEAM(5);
    if (IN(6)) {
        pg8::Gemm g{(const bf16*)(F.ws + WS_YA), (const bf16*)(F.ws + WS_WOUT), T, D, 3072}; S.init(T, D, F.G, (int)blockIdx.x);
        pg8::EpiRes E{x, F.out, MOD0 + 2048, nullptr};
        pg8::gemm_phase<pg8::EpiRes, pg8::StaticOrder, true, true>(F.lds, F.wave, g, S, E);
    } SEAM(6);
    if (IN(7)) { norm_phase(F, F.out, args.in[5], MOD0 + 3072, MOD0 + 4096, (bf16*)(F.ws + WS_H1)); } SEAM(7);
    if (IN(8)) {
        pg8::Gemm g{(const bf16*)(F.ws + WS_H1), (const bf16*)(F.ws + WS_WGU0), T, 2 * FH, D}; S.init(T, 2 * FH, F.G, (int)blockIdx.x);
        pg8::EpiGate<0> E{(bf16*)(F.ws + WS_HID), FH, nullptr, nullptr};
        pg8::gemm_phase<pg8::EpiGate<0>, pg8::StaticOrder, true, true>(F.lds, F.wave, g, S, E);
    } SEAM(8);
    if (IN(9)) {
        pg8::Gemm g{(const bf16*)(F.ws + WS_HID), (const bf16*)(F.ws + WS_WD0), T, D, FH}; S.init(T, D, F.G, (int)blockIdx.x);
        pg8::EpiRes E{F.out, F.out, MOD0 + 5120, nullptr};
        pg8::gemm_phase<pg8::EpiRes, pg8::StaticOrder, true, true>(F.lds, F.wave, g, S, E);
    } SEAM(9);
    if (IN(10)) { norm_phase(F, F.out, args.in[4] + D, MOD1 + 0, MOD1 + 1024, (bf16*)(F.ws + WS_H1)); } SEAM(10);
    if (IN(11)) {
        pg8::Gemm g{(const bf16*)(F.ws + WS_H1), (const bf16*)(F.ws + WS_WC1), T, 2048, D}; S.init(T, 2048, F.G, (int)blockIdx.x);
        pg8::EpiGate<1> E{(bf16*)(F.ws + WS_U), D, args.in[16], args.in[16] + 1024};
        pg8::gemm_phase<pg8::EpiGate<1>, pg8::StaticOrder, true, true>(F.lds, F.wave, g, S, E);
    } SEAM(11);
    if (IN(12)) { dwconv_phase(F, args.in[17], args.in[18], args.in[19], args.in[20]); } SEAM(12);
    if (IN(13)) {
        pg8::Gemm g{(const bf16*)(F.ws + WS_V2), (const bf16*)(F.ws + WS_WC2), T, D, D}; S.init(T, D, F.G, (int)blockIdx.x);
        pg8::EpiRes E{F.out, F.out, MOD1 + 2048, args.in[22]};
        pg8::gemm_phase<pg8::EpiRes, pg8::StaticOrder, true, true>(F.lds, F.wave, g, S, E);
    } SEAM(13);
    if (IN(14)) { norm_phase(F, F.out, args.in[5] + D, MOD1 + 3072, MOD1 + 4096, (bf16*)(F.ws + WS_H1)); } SEAM(14);
    if (IN(15)) {
        pg8::Gemm g{(const bf16*)(F.ws + WS_H1), (const bf16*)(F.ws + WS_WGU1), T, 2 * FH, D}; S.init(T, 2 * FH, F.G, (int)blockIdx.x);
        pg8::EpiGate<0> E{(bf16*)(F.ws + WS_HID), FH, nullptr, nullptr};
        pg8::gemm_phase<pg8::EpiGate<0>, pg8::StaticOrder, true, true>(F.lds, F.wave, g, S, E);
    } SEAM(15);
    if (IN(16)) {
        pg8::Gemm g{(const bf16*)(F.ws + WS_HID), (const bf16*)(F.ws + WS_WD1), T, D, FH}; S.init(T, D, F.G, (int)blockIdx.x);
        pg8::EpiRes E{F.out, F.out, MOD1 + 5120, nullptr};
        pg8::gemm_phase<pg8::EpiRes, pg8::StaticOrder, true, true>(F.lds, F.wave, g, S, E);
    } SEAM(16);
    if (IN(17)) {
        const float* fg = args.in[26];
        for (int m = gw; m < T; m += NGW) {
            const int lane = lane_id(); GAS f32x4* xr = (GAS f32x4*)(F.out + (size_t)m * D) + lane; f32x4 v[4]; float s = 0.f;
#pragma unroll
            for (int j = 0; j < 4; ++j) { v[j] = xr[64 * j]; s += (v[j].x * v[j].x + v[j].y * v[j].y) + (v[j].z * v[j].z + v[j].w * v[j].w); }
            const float rstd = frsq(wave_sum(s) * (1.0f / D) + EPS);
#pragma unroll
            for (int j = 0; j < 4; ++j) xr[64 * j] = (v[j] * rstd) * ((const GAS f32x4*)fg)[lane + 64 * j];
        }
    }
#ifdef PROBE_MASK
    PR_END(17);
    if (blockIdx.x == 0 && F.wave == 0) { const unsigned long long t1 = __builtin_amdgcn_s_memrealtime(); while (__builtin_amdgcn_s_memrealtime() - t1 < (unsigned long long)PROBE_MULT * pr_sum) __builtin_amdgcn_s_sleep(8); }
#endif
#undef IN
#undef SEAM
}

#ifndef MK_N_LAUNCHES
#define MK_N_LAUNCHES 1
#endif
extern "C" void kernel_launch(void* const* d_in, const int* in_sizes, int n_in, void* d_out, int out_size, void* d_ws, size_t ws_size, hipStream_t stream) {
    static int grid = 0;
    if (grid == 0) {
        if (n_in != 27 || in_sizes[0] != T * D || out_size != T * D || ws_size < WS_END) { fprintf(stderr, "kernel_launch: unexpected shapes (n_in %d, in0 %d, out %d, ws %zu); nothing launched\n", n_in, n_in > 0 ? in_sizes[0] : -1, out_size, ws_size); grid = -1; return; }
        int dev = 0, cus = 0, per_cu = 0;
        if (hipGetDevice(&dev) != hipSuccess || hipDeviceGetAttribute(&cus, hipDeviceAttributeMultiprocessorCount, dev) != hipSuccess) { grid = -1; return; }
        if (hipFuncSetAttribute((const void*)mega_fwd, hipFuncAttributeMaxDynamicSharedMemorySize, LDS_BYTES) != hipSuccess) { fprintf(stderr, "kernel_launch: hipFuncSetAttribute failed\n"); grid = -1; return; }
        if (hipOccupancyMaxActiveBlocksPerMultiprocessor(&per_cu, (const void*)mega_fwd, NWAVES * 64, LDS_BYTES) != hipSuccess || per_cu < 1)
            fprintf(stderr, "kernel_launch: note: occupancy query reports %d workgroups per CU\n", per_cu);
        (void)hipGetLastError();
        grid = cus;
    }
    if (grid < 0) return;
    if (hipMemsetAsync((char*)d_ws + WS_CTL, 0, CTL_ZERO_BYTES, stream) != hipSuccess) { fprintf(stderr, "kernel_launch: memset failed\n"); return; }
    Args a{};
    for (int i = 0; i < 27; ++i) a.in[i] = (const float*)d_in[i];
    a.out = (float*)d_out; a.ws = (unsigned char*)d_ws;
#if MK_N_LAUNCHES == 1
    a.ph_lo = 0; a.ph_hi = N_PHASES;
    hipLaunchKernelGGL(mega_fwd, dim3(grid), dim3(NWAVES * 64), LDS_BYTES, stream, a);
#else
    for (int p = 0; p < N_PHASES; ++p) { a.ph_lo = p; a.ph_hi = p + 1; hipLaunchKernelGGL(mega_fwd, dim3(grid), dim3(NWAVES * 64), LDS_BYTES, stream, a); }
#endif
    const hipError_t le = hipPeekAtLastError();
    if (le != hipSuccess) fprintf(stderr, "kernel_launch: launch failed: %s (grid %d)\n", hipGetErrorName(le), grid);
}
```

```cpp
#include <hip/hip_runtime.h>
#include <cstdio>
#include <cstdint>

__device__ __forceinline__ int lane_id() { int l; asm volatile("v_mbcnt_lo_u32_b32 %0, -1, 0\n\tv_mbcnt_hi_u32_b32 %0, -1, %0" : "=v"(l)); return l; }
namespace pg8 {
#define PG8_LAS __attribute__((address_space(3)))
typedef unsigned short bf16_t;
typedef short bf16x8 __attribute__((ext_vector_type(8)));
typedef float f32x4 __attribute__((ext_vector_type(4)));
typedef unsigned u32x4 __attribute__((ext_vector_type(4)));
constexpr int BM = 256, BK = 64, HALF = 128, HTB = HALF * BK * 2, STAGE_BYTES = 8 * HTB, NXCD = 8, WGM = 8;

__host__ __device__ __forceinline__ int lds_byte(int r, int c) { const int st = (r >> 4) * 2 + (c >> 5), rr = r & 15, cc = c & 31, ob = rr * 64 + cc * 2; return st * 1024 + (ob ^ (((ob >> 9) & 1) << 5)); }
__host__ __device__ __forceinline__ void stage_rc(int b, int& R, int& C) { const int st = b / 1024, sb = b % 1024, swz = sb ^ (((sb >> 9) & 1) << 5); R = (st >> 1) * 16 + swz / 64; C = (st & 1) * 32 + (swz % 64) / 2; }
__host__ __device__ __forceinline__ int perm32(int rho) { const int n = rho >> 4, i = rho & 15; return 8 * (i >> 2) + 4 * n + (i & 3); }

struct Unit { int pm, pn; };
struct Gemm { const bf16_t* A; const bf16_t* Bt; int M, N, K; };

struct StaticOrder {
    int nM, nN, nwg, G, c;
    __host__ __device__ void init(int M, int N, int G_, int c_) { nM = M / BM; nN = N / BM; nwg = nM * nN; G = G_; c = c_; }
    __host__ __device__ bool next(int i, Unit& u) const {
        const long L = (long)i * G + c; if (L >= nwg) return false;
        int wgid = (int)L; { const int q = nwg / NXCD, r = nwg % NXCD, xcd = wgid % NXCD, off = wgid / NXCD; wgid = (xcd < r ? xcd * (q + 1) : r * (q + 1) + (xcd - r) * q) + off; }
        const int nig = WGM * nN, gid = wgid / nig, fm = gid * WGM, gsz = (nM - fm) < WGM ? (nM - fm) : WGM;
        u.pm = fm + ((wgid % nig) % gsz); u.pn = (wgid % nig) / gsz; return true;
    }
    __device__ __forceinline__ void a_ready(const Unit&) const {}
    __device__ __forceinline__ void done(const Unit&) const {}
};

__device__ __forceinline__ unsigned cvt_pk_bf16(float lo, float hi) { unsigned r; asm volatile("v_cvt_pk_bf16_f32 %0, %1, %2" : "=v"(r) : "v"(lo), "v"(hi)); return r; }

struct EpiBf16Seg {
    static constexpr bool PERM = true, AFTER_DRAIN = false;
    bf16_t* O0; int ld0; int t1; bf16_t* O1; int ld1; int t2; bf16_t* O2; int ld2;
    bf16_t* halo;
    __device__ __forceinline__ void operator()(const f32x4 (&acc)[2][2][4][2], const Unit& u, int wr, int wc, int fr, int fq) const {
        bf16_t* base; int ld, ct;
        if (u.pn < t1) { base = O0; ld = ld0; ct = u.pn; } else if (u.pn < t2) { base = O1; ld = ld1; ct = u.pn - t1; } else { base = O2; ld = ld2; ct = u.pn - t2; }
        const int row0 = u.pm * BM + wr * 64 + fr, col0 = ct * BM + wc * 32 + 8 * fq;
        const bool do_halo = halo && u.pn >= t1 && u.pn < t2 && ct >= 8 && wr == 1 && fr >= 13;
#pragma unroll
        for (int ai = 0; ai < 2; ++ai)
#pragma unroll
            for (int m = 0; m < 4; ++m) { bf16_t* rowp = base + (size_t)(row0 + ai * HALF + m * 16) * ld + col0;
#pragma unroll
                for (int bj = 0; bj < 2; ++bj) { const f32x4 v0 = acc[ai][bj][m][0], v1 = acc[ai][bj][m][1];
                    u32x4 w; w.x = cvt_pk_bf16(v0[0], v0[1]); w.y = cvt_pk_bf16(v0[2], v0[3]); w.z = cvt_pk_bf16(v1[0], v1[1]); w.w = cvt_pk_bf16(v1[2], v1[3]);
                    *(u32x4*)(rowp + bj * HALF) = w;
                    if (m == 3 && do_halo) *(u32x4*)(halo + ((size_t)((u.pm * 2 + ai) * 3 + (fr - 13))) * 1024 + (col0 - 2048) + bj * HALF) = w; } }
    }
};
__device__ __forceinline__ float sigm(float v) { return __builtin_amdgcn_rcpf(1.0f + __builtin_amdgcn_exp2f(-1.4426950408889634f * v)); }
template <int MODE> struct EpiGate {
    static constexpr bool PERM = true, AFTER_DRAIN = false;
    bf16_t* O; int ldc; const float* ba; const float* bg;
    __device__ __forceinline__ void operator()(const f32x4 (&acc)[2][2][4][2], const Unit& u, int wr, int wc, int fr, int fq) const {
        const int row0 = u.pm * BM + wr * 64 + fr, col0 = u.pn * HALF + wc * 32 + 8 * fq;
        f32x4 bav[2], bgv[2];
#pragma unroll
        for (int n = 0; n < 2; ++n) { if (MODE == 1) { bav[n] = *(const f32x4*)(ba + col0 + 4 * n); bgv[n] = *(const f32x4*)(bg + col0 + 4 * n); } else { bav[n] = (f32x4){0.f, 0.f, 0.f, 0.f}; bgv[n] = bav[n]; } }
#pragma unroll
        for (int ai = 0; ai < 2; ++ai)
#pragma unroll
            for (int m = 0; m < 4; ++m) { bf16_t* rowp = O + (size_t)(row0 + ai * HALF + m * 16) * ldc + col0; float r[8];
#pragma unroll
                for (int n = 0; n < 2; ++n)
#pragma unroll
                    for (int j = 0; j < 4; ++j) { const float a = acc[ai][0][m][n][j] + bav[n][j], b = acc[ai][1][m][n][j] + bgv[n][j];
                        r[4 * n + j] = (MODE == 0) ? a * sigm(a) * b : a * sigm(b); }
                u32x4 w; w.x = cvt_pk_bf16(r[0], r[1]); w.y = cvt_pk_bf16(r[2], r[3]); w.z = cvt_pk_bf16(r[4], r[5]); w.w = cvt_pk_bf16(r[6], r[7]);
                *(u32x4*)rowp = w; }
    }
};
struct EpiRes {
    static constexpr bool PERM = false, AFTER_DRAIN = false;
    const float* base; float* out; const float* gate; const float* bias;
    __device__ __forceinline__ void operator()(const f32x4 (&acc)[2][2][4][2], const Unit& u, int wr, int wc, int fr, int fq) const {
        const int row0 = u.pm * BM + wr * 64 + fr, col0 = u.pn * BM + wc * 32 + 4 * fq;
        const float* gp = gate + (size_t)(u.pm >> 4) * 6144 + col0;
        f32x4 gv[2][2], bv[2][2];
#pragma unroll
        for (int bj = 0; bj < 2; ++bj)
#pragma unroll
            for (int n = 0; n < 2; ++n) { gv[bj][n] = *(const f32x4*)(gp + bj * HALF + n * 16); bv[bj][n] = bias ? *(const f32x4*)(bias + col0 + bj * HALF + n * 16) : (f32x4){0.f, 0.f, 0.f, 0.f}; }
#pragma unroll
        for (int ai = 0; ai < 2; ++ai)
#pragma unroll
            for (int m = 0; m < 4; ++m) { const size_t off = (size_t)(row0 + ai * HALF + m * 16) * 1024 + col0;
#pragma unroll
                for (int bj = 0; bj < 2; ++bj)
#pragma unroll
                    for (int n = 0; n < 2; ++n) { const f32x4 bs = *(const f32x4*)(base + off + bj * HALF + n * 16);
                        *(f32x4*)(out + off + bj * HALF + n * 16) = bs + gv[bj][n] * (acc[ai][bj][m][n] + bv[bj][n]); }
                if (m & 1) asm volatile("" ::: "memory"); }
    }
};

template <class Epi, class Sched, bool ALIGN_EPI = false, bool SP2 = false>
__device__ __forceinline__ void gemm_phase(PG8_LAS unsigned char* lds, int wid, const Gemm g, const Sched& S, const Epi& E) {
    const int lane = lane_id(), tid = wid * 64 + lane, wr = wid >> 2, wc = wid & 3, fr = lane & 15, fq = lane >> 4;
    const int K = g.K, nt = K / BK;
    unsigned voffA[2], voffB[2];
#pragma unroll
    for (int i = 0; i < 2; ++i) { int R, C; stage_rc(tid * 16 + i * 8192, R, C); const int Rb = Epi::PERM ? ((R & ~31) + perm32(R & 31)) : R;
        voffA[i] = (unsigned)(R * K + C) * 2u; voffB[i] = (unsigned)(Rb * K + C) * 2u; }
    const size_t kstep = (size_t)(BK * 2);
    const size_t hstep = (size_t)HALF * K * 2;
    const size_t tstep = 2 * hstep;
    const unsigned ldsw = (unsigned)wid * 1024u;
    const int aoff = lds_byte(wr * 64 + fr, fq * 8), boff = lds_byte(wc * 32 + fr, fq * 8);
#define PG8_SA(b, h) (((b) * 2 + (h)) * HTB)
#define PG8_SB(b, h) ((4 + (b) * 2 + (h)) * HTB)
#define PG8_STAGE(bufoff, gbase, voff) do { _Pragma("unroll") for (int _i = 0; _i < 2; ++_i) \
        __builtin_amdgcn_global_load_lds((const unsigned*)((const char*)(gbase) + (voff)[_i]), (PG8_LAS unsigned*)(lds + (bufoff) + ldsw + _i * 8192), 16, 0, 0); } while (0)
#define PG8_LDA(dst, b, h) do { _Pragma("unroll") for (int m = 0; m < 4; ++m) _Pragma("unroll") for (int k = 0; k < 2; ++k) dst[m][k] = *(const PG8_LAS bf16x8*)(lds + PG8_SA(b, h) + aoff + m * 2048 + k * 1024); } while (0)
#define PG8_LDB(dst, b, h) do { _Pragma("unroll") for (int n = 0; n < 2; ++n) _Pragma("unroll") for (int k = 0; k < 2; ++k) dst[n][k] = *(const PG8_LAS bf16x8*)(lds + PG8_SB(b, h) + boff + n * 2048 + k * 1024); } while (0)
#define PG8_MMA(ai, bj, At, Bt) do { __builtin_amdgcn_s_setprio(1); _Pragma("unroll") for (int m = 0; m < 4; ++m) _Pragma("unroll") for (int n = 0; n < 2; ++n) _Pragma("unroll") for (int k = 0; k < 2; ++k) \
        acc[ai][bj][m][n] = __builtin_amdgcn_mfma_f32_16x16x32_bf16(Bt[n][k], At[m][k], acc[ai][bj][m][n], 0, 0, 0); __builtin_amdgcn_s_setprio(0); } while (0)
#define PG8_WAIT_V(n) asm volatile("s_waitcnt vmcnt(" #n ")" ::: "memory")
#define PG8_WAIT_L(n) asm volatile("s_waitcnt lgkmcnt(" #n ")" ::: "memory")
#define PG8_BAR __builtin_amdgcn_s_barrier()
#define PG8_SCHED __builtin_amdgcn_sched_barrier(0)
    Unit cur, nxt; int ui = 0;
    if (!S.next(0, cur)) return;
    f32x4 acc[2][2][4][2];
#pragma unroll
    for (int a = 0; a < 2; ++a)
#pragma unroll
        for (int b = 0; b < 2; ++b)
#pragma unroll
            for (int m = 0; m < 4; ++m)
#pragma unroll
                for (int n = 0; n < 2; ++n) acc[a][b][m][n] = (f32x4){0.f, 0.f, 0.f, 0.f};
    bf16x8 At[4][2], B0[2][2], B1[2][2];
    const char* cA = (const char*)g.A + (size_t)cur.pm * tstep; const char* cB = (const char*)g.Bt + (size_t)cur.pn * tstep;
    S.a_ready(cur);
    if constexpr (SP2) {
        PG8_STAGE(PG8_SB(0, 0), cB, voffB); PG8_STAGE(PG8_SB(0, 1), cB + hstep, voffB); PG8_STAGE(PG8_SA(0, 0), cA, voffA); PG8_STAGE(PG8_SA(0, 1), cA + hstep, voffA);
        if (wr == 1) PG8_BAR;
        PG8_WAIT_V(2); PG8_BAR;
        PG8_STAGE(PG8_SB(1, 0), cB + kstep, voffB); PG8_STAGE(PG8_SA(1, 0), cA + kstep, voffA); PG8_STAGE(PG8_SB(1, 1), cB + hstep + kstep, voffB);
        PG8_WAIT_V(6); PG8_BAR;
    } else {
        PG8_STAGE(PG8_SB(0, 0), cB, voffB); PG8_STAGE(PG8_SA(0, 0), cA, voffA); PG8_STAGE(PG8_SB(0, 1), cB + hstep, voffB); PG8_STAGE(PG8_SA(0, 1), cA + hstep, voffA);
        if (wr == 1) PG8_BAR;
        PG8_WAIT_V(4); PG8_BAR;
        PG8_STAGE(PG8_SB(1, 0), cB + kstep, voffB); PG8_STAGE(PG8_SA(1, 0), cA + kstep, voffA); PG8_STAGE(PG8_SB(1, 1), cB + hstep + kstep, voffB);
        PG8_WAIT_V(6); PG8_BAR;
    }
    for (;;) {
        const bool has_next = S.next(ui + 1, nxt);
        const char* nA = has_next ? (const char*)g.A + (size_t)nxt.pm * tstep : cA; const char* nB = has_next ? (const char*)g.Bt + (size_t)nxt.pn * tstep : cB;
        for (int t = 0; t < nt; t += 2) {
            const bool last = (t == nt - 2);
            const char* a1 = cA + (size_t)(t + 1) * kstep;
            const char* a2 = last ? nA : cA + (size_t)(t + 2) * kstep; const char* b2 = last ? nB : cB + (size_t)(t + 2) * kstep;
            const char* a3 = a2 + kstep; const char* b3 = b2 + kstep;
            if (last && has_next) S.a_ready(nxt);
            if constexpr (SP2) {
            PG8_LDB(B0, 0, 0); PG8_LDB(B1, 0, 1); PG8_SCHED; PG8_LDA(At, 0, 0); PG8_STAGE(PG8_SA(1, 1), a1 + hstep, voffA);
            PG8_WAIT_V(8); PG8_WAIT_L(0); PG8_BAR; PG8_MMA(0, 0, At, B0); PG8_MMA(0, 1, At, B1); PG8_BAR; PG8_SCHED;
            PG8_LDA(At, 0, 1); PG8_STAGE(PG8_SB(0, 0), b2, voffB); PG8_STAGE(PG8_SB(0, 1), b2 + hstep, voffB); PG8_STAGE(PG8_SA(0, 0), a2, voffA);
            PG8_WAIT_V(8); PG8_WAIT_L(0); PG8_BAR; PG8_MMA(1, 0, At, B0); PG8_MMA(1, 1, At, B1); PG8_BAR; PG8_SCHED;
            PG8_LDB(B0, 1, 0); PG8_LDB(B1, 1, 1); PG8_SCHED; PG8_LDA(At, 1, 0); PG8_STAGE(PG8_SA(0, 1), a2 + hstep, voffA);
            PG8_WAIT_V(8); PG8_WAIT_L(0); PG8_BAR; PG8_MMA(0, 0, At, B0); PG8_MMA(0, 1, At, B1); PG8_BAR; PG8_SCHED;
            PG8_LDA(At, 1, 1); PG8_STAGE(PG8_SB(1, 0), b3, voffB); PG8_STAGE(PG8_SB(1, 1), b3 + hstep, voffB); PG8_STAGE(PG8_SA(1, 0), a3, voffA);
            PG8_WAIT_V(8); PG8_WAIT_L(0); PG8_BAR; PG8_MMA(1, 0, At, B0); PG8_MMA(1, 1, At, B1); PG8_BAR; PG8_SCHED;
            } else {
            PG8_LDB(B0, 0, 0); PG8_SCHED; PG8_LDA(At, 0, 0); PG8_STAGE(PG8_SA(1, 1), a1 + hstep, voffA);
            PG8_WAIT_L(8); PG8_BAR; PG8_WAIT_L(0); PG8_MMA(0, 0, At, B0); PG8_BAR; PG8_SCHED;
            PG8_LDB(B1, 0, 1); PG8_STAGE(PG8_SB(0, 0), b2, voffB);
            PG8_BAR; PG8_WAIT_L(0); PG8_MMA(0, 1, At, B1); PG8_BAR;
            PG8_LDA(At, 0, 1); PG8_STAGE(PG8_SA(0, 0), a2, voffA);
            PG8_BAR; PG8_WAIT_L(0); PG8_MMA(1, 0, At, B0); PG8_BAR; PG8_SCHED;
            PG8_STAGE(PG8_SB(0, 1), b2 + hstep, voffB);
            PG8_WAIT_V(6); PG8_BAR; PG8_MMA(1, 1, At, B1); PG8_BAR;
            PG8_LDB(B0, 1, 0); PG8_SCHED; PG8_LDA(At, 1, 0); PG8_STAGE(PG8_SA(0, 1), a2 + hstep, voffA);
            PG8_WAIT_L(8); PG8_BAR; PG8_WAIT_L(0); PG8_MMA(0, 0, At, B0); PG8_BAR; PG8_SCHED;
            PG8_LDB(B1, 1, 1); PG8_STAGE(PG8_SB(1, 0), b3, voffB);
            PG8_BAR; PG8_WAIT_L(0); PG8_MMA(0, 1, At, B1); PG8_BAR;
            PG8_LDA(At, 1, 1); PG8_STAGE(PG8_SA(1, 0), a3, voffA);
            PG8_BAR; PG8_WAIT_L(0); PG8_MMA(1, 0, At, B0); PG8_BAR; PG8_SCHED;
            PG8_STAGE(PG8_SB(1, 1), b3 + hstep, voffB);
            PG8_WAIT_V(6); PG8_BAR; PG8_MMA(1, 1, At, B1); PG8_BAR;
            }
        }
        if constexpr (ALIGN_EPI) { if (wr == 0) PG8_BAR; }
        if constexpr (!Epi::AFTER_DRAIN) { E(acc, cur, wr, wc, fr, fq); S.done(cur); }
        if (!has_next) break;
#pragma unroll
        for (int a = 0; a < 2; ++a)
#pragma unroll
            for (int b = 0; b < 2; ++b)
#pragma unroll
                for (int m = 0; m < 4; ++m)
#pragma unroll
                    for (int n = 0; n < 2; ++n) acc[a][b][m][n] = (f32x4){0.f, 0.f, 0.f, 0.f};
        cur = nxt; cA = nA; cB = nB; ++ui;
        if constexpr (ALIGN_EPI) { if (wr == 1) PG8_BAR; }
    }
    PG8_WAIT_V(0);
    if constexpr (!ALIGN_EPI) { if (wr == 0) PG8_BAR; }
    PG8_BAR;
#undef PG8_SA
#undef PG8_SB
#undef PG8_STAGE
#undef PG8_LDA
#undef PG8_LDB
#undef PG8_MMA
#undef PG8_WAIT_V
#undef PG8_WAIT_L
#undef PG8_BAR
#undef PG8_SCHED
}
}

constexpr int NWAVES = 8;
constexpr int NB = 4, SEQ = 4096, D = 1024, T = NB * SEQ;
constexpr int DI = 2048, NH = 32, HP = 64, NS = 128, CONVD = 3072, CHUNK = 128, NCHUNK = SEQ / CHUNK;
constexpr int AH = 16, AHD = 64, QW = 3072;
constexpr int FH = 2816;
constexpr int N_PHASES = 18;
constexpr float EPS = 1e-6f;

constexpr size_t MiB = 1u << 20;
constexpr size_t WS_CTL = 0, CTL_ZERO_BYTES = 1 * MiB;
constexpr size_t WS_MOD = 1 * MiB;
constexpr size_t WS_DT = 2 * MiB;
constexpr size_t WS_LSE = 4 * MiB;
constexpr size_t WS_PSSQ = 7 * MiB;
constexpr size_t WS_WDT = 9 * MiB;
constexpr size_t WS_WZX = 10 * MiB;
constexpr size_t WS_WQKV = 20 * MiB;
constexpr size_t WS_H = 30 * MiB;
constexpr size_t WS_BIG = 62 * MiB;
constexpr size_t WS_YA = 158 * MiB;
constexpr size_t WS_WOUT = 10 * MiB;
constexpr size_t WS_WGU0 = 16 * MiB;
constexpr size_t WS_WD0 = 27 * MiB;
constexpr size_t WS_WC1 = 33 * MiB;
constexpr size_t WS_WC2 = 37 * MiB;
constexpr size_t WS_WGU1 = 39 * MiB;
constexpr size_t WS_WD1 = 50 * MiB;
constexpr size_t WS_H1 = 62 * MiB;
constexpr size_t WS_HID = 94 * MiB;
constexpr size_t WS_U = 182 * MiB;
constexpr size_t WS_V2 = 214 * MiB;
constexpr size_t WS_HALO = 254 * MiB;
constexpr size_t WS_END = 256 * MiB;
constexpr int CW_BAR = 4096;

constexpr int LDS_BYTES = 163840;
constexpr int MISC_OFF = LDS_BYTES - 256;

#define GAS __attribute__((address_space(1)))
#define LAS __attribute__((address_space(3)))
typedef unsigned short bf16;
typedef unsigned v4u __attribute__((ext_vector_type(4)));
typedef unsigned v2u __attribute__((ext_vector_type(2)));
typedef float f32x4 __attribute__((ext_vector_type(4)));
typedef float f32x16 __attribute__((ext_vector_type(16)));
typedef short bf16x8 __attribute__((ext_vector_type(8)));
typedef short s16x4 __attribute__((ext_vector_type(4)));
typedef GAS unsigned gu32;
#define RLX_AGENT __ATOMIC_RELAXED, __HIP_MEMORY_SCOPE_AGENT
#define LDS_WAIT() asm volatile("s_waitcnt lgkmcnt(0)" ::: "memory")
#define VM_WAIT() asm volatile("s_waitcnt vmcnt(0)" ::: "memory")
__device__ __forceinline__ unsigned f2bf(float f) { unsigned u = __builtin_bit_cast(unsigned, f); return (u + 0x7fffu + ((u >> 16) & 1u)) >> 16; }
typedef float f32x2_t __attribute__((ext_vector_type(2))); typedef __bf16 bf16x2_t __attribute__((ext_vector_type(2)));
__device__ __forceinline__ unsigned pk2(float lo, float hi) { f32x2_t v = {lo, hi}; bf16x2_t b = __builtin_convertvector(v, bf16x2_t); return __builtin_bit_cast(unsigned, b); }
__device__ __forceinline__ float bflo(unsigned w) { return __builtin_bit_cast(float, w << 16); }
__device__ __forceinline__ float bfhi(unsigned w) { return __builtin_bit_cast(float, w & 0xffff0000u); }
__device__ __forceinline__ float fexp(float v) { return __builtin_amdgcn_exp2f(1.4426950408889634f * v); }
__device__ __forceinline__ float siluf(float v) { return v * __builtin_amdgcn_rcpf(1.0f + fexp(-v)); }

__device__ const unsigned char T5_BUCKET[3][132] = {
{0,1,2,3,4,5,6,7,8,9,10,11,12,13,14,15,16,16,16,16,16,16,17,17,17,17,17,17,17,17,18,18,18,18,18,18,18,18,18,18,19,19,19,19,19,19,19,19,19,19,19,19,19,19,20,20,20,20,20,20,20,20,20,20,20,20,20,20,20,20,20,20,20,21,21,21,21,21,21,21,21,21,21,21,21,21,21,21,21,21,21,21,21,21,21,21,21,21,21,22,22,22,22,22,22,22,22,22,22,22,22,22,22,22,22,22,22,22,22,22,22,22,22,22,22,22,22,22,22},
{0,4,8,12,16,16,17,17,18,18,19,19,19,19,20,20,20,20,20,21,21,21,21,21,21,22,22,22,22,22,22,22,22,22,23,23,23,23,23,23,23,23,23,23,23,23,24,24,24,24,24,24,24,24,24,24,24,24,24,24,24,24,25,25,25,25,25,25,25,25,25,25,25,25,25,25,25,25,25,25,25,25,25,26,26,26,26,26,26,26,26,26,26,26,26,26,26,26,26,26,26,26,26,26,26,26,26,26,26,26,26,26,26,27,27,27,27,27,27,27,27,27,27,27,27,27,27,27,27},
{0,16,18,19,20,21,21,22,22,23,23,23,24,24,24,24,25,25,25,25,25,26,26,26,26,26,26,26,26,27,27,27,27,27,27,27,27,27,27,28,28,28,28,28,28,28,28,28,28,28,28,28,29,29,29,29,29,29,29,29,29,29,29,29,29,29,29,29,29,29,30,30,30,30,30,30,30,30,30,30,30,30,30,30,30,30,30,30,30,30,30,30,30,30,30,31,31,31,31,31,31,31,31,31,31,31,31,31,31,31,31,31,31,31,31,31,31,31,31,31,31,31,31,31,31,31,31,31,31}};

#define XB_TMO      128
#define XB_XCNT(j)  (256  + 64 * (j))
#define XB_XSUB(j)  (1280 + 64 * (j))
#define XB_XGEN(j)  (2304 + 64 * (j))
#define XB_TOP      3328
#define XB_TOPGEN   3392
#define XCD_BAR_WORDS 3456
#define XB_SPIN_CAP (1u << 18)
__device__ __forceinline__ unsigned xb_ld(unsigned* p)              { return __hip_atomic_load(p, __ATOMIC_RELAXED, __HIP_MEMORY_SCOPE_AGENT); }
__device__ __forceinline__ unsigned xb_add(unsigned* p, unsigned v) { return __hip_atomic_fetch_add(p, v, __ATOMIC_RELAXED, __HIP_MEMORY_SCOPE_AGENT); }
__device__ __forceinline__ unsigned xb_xcc_id() { return (unsigned)__builtin_amdgcn_s_getreg((3 << 11) | 20) & 0xFu; }
#define XB_SPIN(cond, bar) do { unsigned _sp = 0; while (cond) { __builtin_amdgcn_s_sleep(1); \
    if ((++_sp & 255u) == 0u) { if (xb_ld(&(bar)[XB_TMO])) break; if (_sp > XB_SPIN_CAP) { atomicAdd(&(bar)[XB_TMO], 1u); break; } } } } while (0)
struct XcdBarrier { unsigned* bar; unsigned x; volatile LAS unsigned* st; };
__device__ __forceinline__ XcdBarrier xcd_barrier_post(unsigned* bar, volatile LAS unsigned* st, bool leader) {
    XcdBarrier b; b.bar = bar; b.x = xb_xcc_id(); b.st = st;
    if (leader) (void)xb_add(&bar[XB_XCNT(b.x)], 1u);
    return b;
}
__device__ __forceinline__ void xcd_barrier_complete(unsigned* bar, unsigned x, unsigned& nloc, unsigned& nx) {
    const unsigned G = gridDim.x * gridDim.y * gridDim.z;
    unsigned sum, cnt, mine, sp = 0u;
    for (;;) {
        sum = 0u; cnt = 0u; mine = 0u;
#pragma unroll
        for (unsigned j = 0; j < 16; ++j) { const unsigned c = xb_ld(&bar[XB_XCNT(j)]); sum += c; cnt += (c > 0u) ? 1u : 0u; mine = (j == x) ? c : mine; }
        if (sum == G) break;
        __builtin_amdgcn_s_sleep(1);
        if ((++sp & 255u) == 0u) { if (xb_ld(&bar[XB_TMO])) break; if (sp > XB_SPIN_CAP) { atomicAdd(&bar[XB_TMO], 1u); break; } }
    }
    nloc = mine > 0u ? mine : 1u; nx = cnt > 0u ? cnt : 1u;
}
__device__ __forceinline__ void xcd_barrier(const XcdBarrier& b, int wave) {
    asm volatile("s_waitcnt vmcnt(0)" ::: "memory");
    __syncthreads();
    if (wave == 0 && lane_id() == 0) {
        unsigned* bar = b.bar;
        __builtin_amdgcn_s_waitcnt(0);
        unsigned nloc = b.st[0], nx = b.st[1];
        if (nloc == 0u) { xcd_barrier_complete(bar, b.x, nloc, nx); b.st[0] = nloc; b.st[1] = nx; }
        const unsigned old = xb_add(&bar[XB_XSUB(b.x)], 1u);
        const unsigned gen = old / nloc;
        if (old + 1u == (gen + 1u) * nloc) {
            __builtin_amdgcn_fence(__ATOMIC_RELEASE, "agent");
            asm volatile("s_waitcnt vmcnt(0)" ::: "memory");
            const unsigned og = xb_add(&bar[XB_TOP], 1u);
            const unsigned tg = og / nx;
            if (og + 1u == (tg + 1u) * nx) xb_add(&bar[XB_TOPGEN], 1u);
            else XB_SPIN(xb_ld(&bar[XB_TOPGEN]) == tg, bar);
            __builtin_amdgcn_fence(__ATOMIC_ACQUIRE, "agent");
            xb_add(&bar[XB_XGEN(b.x)], 1u);
            asm volatile("s_waitcnt vmcnt(0)" ::: "memory");
        } else {
            XB_SPIN(xb_ld(&bar[XB_XGEN(b.x)]) == gen, bar);
            __builtin_amdgcn_fence(__ATOMIC_ACQUIRE, "agent");
            asm volatile("s_waitcnt vmcnt(0)" ::: "memory");
        }
    }
    __syncthreads();
}

struct Frame {
    LAS unsigned char* lds;
    int wave;
    int vcu, G;
    const float* const* in;
    unsigned char* ws; float* out;
};
template <int K> __device__ __forceinline__ float swz_xor(float v) { return __builtin_bit_cast(float, __builtin_amdgcn_ds_swizzle(__builtin_bit_cast(int, v), 0x1f | (K << 10))); }
__device__ __forceinline__ float frsq(float v) { return __builtin_amdgcn_rsqf(v); }
__device__ __forceinline__ float wave_sum(float v) {
#pragma unroll
    for (int o = 1; o < 64; o <<= 1) v += __shfl_xor(v, o);
    return v;
}
__device__ __forceinline__ int rowidx(int r, int hh) { return (r & 3) + 8 * (r >> 2) + 4 * hh; }

__device__ __forceinline__ void transpose_block(const float* Wsrc, int N, bf16* dst, int Kd, LAS float* scr, int lane) {
#pragma unroll 8
    for (int i = 0; i < 32; ++i) { const int kk = 2 * i + (lane >> 5); scr[kk * 33 + (lane & 31)] = Wsrc[(size_t)kk * N + (lane & 31)]; }
    LDS_WAIT(); asm volatile("" ::: "memory");
    const int c = lane & 7;
#pragma unroll
    for (int j = 0; j < 4; ++j) { const int n = (lane >> 3) + 8 * j; const LAS float* s = scr + (8 * c) * 33 + n;
        v4u o; o.x = pk2(s[0 * 33], s[1 * 33]); o.y = pk2(s[2 * 33], s[3 * 33]); o.z = pk2(s[4 * 33], s[5 * 33]); o.w = pk2(s[6 * 33], s[7 * 33]);
        *(GAS v4u*)(dst + (size_t)n * Kd + 8 * c) = o; }
    LDS_WAIT(); asm volatile("" ::: "memory");
}
__device__ __forceinline__ void cvt_win_item(const float* w_in, unsigned char* ws, int kb, int nb, LAS float* scr, int lane) {
    const int n0 = 32 * nb; bf16* dst;
    if (n0 < 5120) dst = (bf16*)(ws + WS_WZX) + (size_t)n0 * 1024;
    else if (n0 == 5120) dst = (bf16*)(ws + WS_WDT);
    else dst = (bf16*)(ws + WS_WQKV) + (size_t)(n0 - 5152) * 1024;
    transpose_block(w_in + (size_t)(64 * kb) * 10272 + n0, 10272, dst + 64 * kb, 1024, scr, lane);
}
__device__ __forceinline__ void cvt_plain_item(const float* W, int K, int N, bf16* WT, int item, LAS float* scr, int lane) {
    const int nblk = N / 32, kb = item / nblk, nb = item % nblk;
    transpose_block(W + (size_t)(64 * kb) * N + 32 * nb, N, WT + (size_t)(32 * nb) * K + 64 * kb, K, scr, lane);
}
__device__ __forceinline__ void cvt_pair_item(const float* W, int K, int Nsrc, int coff, int Nhalf, int sel, bf16* WT, int item, LAS float* scr, int lane) {
    const int nblk = Nhalf / 32, kb = item / nblk, nb = item % nblk, n0 = 32 * nb;
    const int drow = (n0 >> 7) * 256 + sel * 128 + (n0 & 127);
    transpose_block(W + (size_t)(64 * kb) * Nsrc + coff + n0, Nsrc, WT + (size_t)drow * K + 64 * kb, K, scr, lane);
}

__device__ __forceinline__ void adaln_row(const float* xrow, const float* g, const float* sc, const float* sh, int lane, unsigned (&pk)[4][2]) {
    const GAS f32x4* xr = (const GAS f32x4*)xrow + lane;
    f32x4 v[4]; float s = 0.f;
#pragma unroll
    for (int j = 0; j < 4; ++j) { v[j] = xr[64 * j]; s += (v[j].x * v[j].x + v[j].y * v[j].y) + (v[j].z * v[j].z + v[j].w * v[j].w); }
    const float rstd = frsq(wave_sum(s) * (1.0f / D) + EPS);
#pragma unroll
    for (int j = 0; j < 4; ++j) {
        const f32x4 gv = ((const GAS f32x4*)g)[lane + 64 * j], scv = ((const GAS f32x4*)sc)[lane + 64 * j], shv = ((const GAS f32x4*)sh)[lane + 64 * j];
        const f32x4 hv = (v[j] * rstd) * gv * (scv + 1.0f) + shv;
        pk[j][0] = pk2(hv.x, hv.y); pk[j][1] = pk2(hv.z, hv.w);
    }
}
__device__ __forceinline__ void norm_phase(Frame& F, const float* X, const float* g, const float* modsh, const float* modsc, bf16* out) {
    const int gw = F.vcu * NWAVES + F.wave, NGW = F.G * NWAVES, lane = lane_id();
    for (int m = gw; m < T; m += NGW) {
        const int b = m >> 12; unsigned pk[4][2];
        adaln_row(X + (size_t)m * D, g, modsc + (size_t)b * 6144, modsh + (size_t)b * 6144, lane, pk);
        GAS v2u* o8 = (GAS v2u*)(out + (size_t)m * D) + lane;
#pragma unroll
        for (int j = 0; j < 4; ++j) o8[64 * j] = (v2u){pk[j][0], pk[j][1]};
    }
}

__device__ __forceinline__ void p0_phase(Frame& F, const float* c, const float* ada_w, const float* ada_b, const float* w_in) {
    LAS float* cs = (LAS float*)(F.lds);
    LAS float* red = (LAS float*)(F.lds + 16384);
    float* MOD = (float*)(F.ws + WS_MOD);
    const int lane = lane_id(), tid = F.wave * 64 + lane;
    if (F.vcu < 192) {
        for (int i = tid; i < 4096; i += NWAVES * 64) cs[i] = siluf(c[i]);
        __syncthreads();
        for (int cb = F.vcu; cb < 192; cb += F.G) {
            const int gc = cb * 64 + lane, li = gc / 6144, n = gc % 6144;
            const float* w = ada_w + (size_t)li * 1024 * 6144 + n;
            float a0 = 0.f, a1 = 0.f, a2 = 0.f, a3 = 0.f;
            const int k0 = F.wave * 128;
#pragma unroll 8
            for (int k = k0; k < k0 + 128; ++k) { const float wv = w[(size_t)k * 6144]; a0 += cs[k] * wv; a1 += cs[1024 + k] * wv; a2 += cs[2048 + k] * wv; a3 += cs[3072 + k] * wv; }
            red[(F.wave * 4 + 0) * 64 + lane] = a0; red[(F.wave * 4 + 1) * 64 + lane] = a1; red[(F.wave * 4 + 2) * 64 + lane] = a2; red[(F.wave * 4 + 3) * 64 + lane] = a3;
            __syncthreads();
            if (tid < 256) { const int b = tid >> 6, l = tid & 63; float s = 0.f;
#pragma unroll
                for (int w8 = 0; w8 < 8; ++w8) s += red[(w8 * 4 + b) * 64 + l];
                const int gc2 = cb * 64 + l, li2 = gc2 / 6144, n2 = gc2 % 6144;
                MOD[(size_t)(li2 * 4 + b) * 6144 + n2] = s + ada_b[(size_t)li2 * 6144 + n2]; }
            __syncthreads();
        }
    }
    LAS float* scr = (LAS float*)(F.lds + 32768 + F.wave * 8704);
    const int gw = F.vcu * NWAVES + F.wave, NGW = F.G * NWAVES;
    for (int it = gw; it < 161 * 16; it += NGW) cvt_win_item(w_in, F.ws, it / 161, it % 161, scr, lane);
}

__device__ __forceinline__ void p1_phase(Frame& F, const float* x, const float* g, const float* dt_bias) {
    const float* MOD = (const float*)(F.ws + WS_MOD);
    bf16* H = (bf16*)(F.ws + WS_H); float* DT = (float*)(F.ws + WS_DT); const bf16* WDT = (const bf16*)(F.ws + WS_WDT);
    constexpr int HRS = 2064;
    const int lane = lane_id(), tid = F.wave * 64 + lane;
    for (int rg = F.vcu; rg < T / 64; rg += F.G) {
#pragma unroll 1
        for (int i = 0; i < 8; ++i) {
            const int rl = F.wave * 8 + i, m = rg * 64 + rl, b = m >> 12; unsigned pk[4][2];
            adaln_row(x + (size_t)m * D, g, MOD + (size_t)b * 6144 + 1024, MOD + (size_t)b * 6144 + 0, lane, pk);
            GAS v2u* o8 = (GAS v2u*)(H + (size_t)m * D) + lane;
#pragma unroll
            for (int j = 0; j < 4; ++j) { o8[64 * j] = (v2u){pk[j][0], pk[j][1]}; *(LAS v2u*)(F.lds + rl * HRS + (4 * lane + 256 * j) * 2) = (v2u){pk[j][0], pk[j][1]}; }
        }
        __syncthreads();
        const int mt = F.wave & 1, kq = F.wave >> 1, r32 = lane & 31, hh = lane >> 5;
        f32x16 acc = {};
        const LAS unsigned char* ap = F.lds + (32 * mt + r32) * HRS + (256 * kq + 8 * hh) * 2;
        const bf16* bp = WDT + (size_t)r32 * 1024 + 256 * kq + 8 * hh;
#pragma unroll 4
        for (int s = 0; s < 16; ++s) { const bf16x8 a = *(const LAS bf16x8*)(ap + 32 * s); const bf16x8 bb = *(const GAS bf16x8*)(bp + 16 * s); acc = __builtin_amdgcn_mfma_f32_32x32x16_bf16(a, bb, acc, 0, 0, 0); }
        __syncthreads();
        LAS float* red = (LAS float*)F.lds;
#pragma unroll
        for (int r = 0; r < 16; ++r) red[((kq * 2 + mt) * 32 + rowidx(r, hh)) * 32 + r32] = acc[r];
        __syncthreads();
#pragma unroll
        for (int i = 0; i < 4; ++i) { const int o = tid + 512 * i, row = o >> 5, col = o & 31; float s = 0.f;
#pragma unroll
            for (int q = 0; q < 4; ++q) s += red[((q * 2 + (row >> 5)) * 32 + (row & 31)) * 32 + col];
            const float v = s + dt_bias[col];
            const float sp = fmaxf(v, 0.f) + log1pf(__expf(-fabsf(v)));
            DT[(size_t)(rg * 64 + row) * 32 + col] = sp; }
        __syncthreads();
    }
}

__device__ __forceinline__ f32x16 mma_lds(f32x16 acc, const LAS unsigned char* A, const LAS unsigned char* B, int ksteps, int lane) {
    const int r = lane & 31, hh = lane >> 5;
    const LAS unsigned char* pa = A + r * 272 + hh * 16; const LAS unsigned char* pb = B + r * 272 + hh * 16;
    for (int s = 0; s < ksteps; ++s) { const bf16x8 a = *(const LAS bf16x8*)(pa + 32 * s); const bf16x8 bb = *(const LAS bf16x8*)(pb + 32 * s); acc = __builtin_amdgcn_mfma_f32_32x32x16_bf16(a, bb, acc, 0, 0, 0); }
    return acc;
}
template <int NTOK> __device__ __forceinline__ void conv8(const bf16* XBC, int b, int tfirst, int col, const float* conv_w, const float* conv_b, float (&val)[NTOK][8]) {
    f32x4 w[4][2];
#pragma unroll
    for (int k = 0; k < 4; ++k) { w[k][0] = *(const GAS f32x4*)(conv_w + (size_t)k * CONVD + col); w[k][1] = *(const GAS f32x4*)(conv_w + (size_t)k * CONVD + col + 4); }
    const f32x4 b0 = *(const GAS f32x4*)(conv_b + col), b1 = *(const GAS f32x4*)(conv_b + col + 4);
    v4u raw[NTOK + 3];
#pragma unroll
    for (int i = 0; i < NTOK + 3; ++i) { const int t = tfirst - 3 + i;
        raw[i] = (t >= 0) ? *(const GAS v4u*)(XBC + ((size_t)b * SEQ + t) * CONVD + col) : (v4u){0u, 0u, 0u, 0u}; }
#pragma unroll
    for (int o = 0; o < NTOK; ++o) {
        float a[8] = {b0.x, b0.y, b0.z, b0.w, b1.x, b1.y, b1.z, b1.w};
#pragma unroll
        for (int k = 0; k < 4; ++k) { const v4u rw = raw[o + k];
            a[0] += w[k][0].x * bflo(rw.x); a[1] += w[k][0].y * bfhi(rw.x); a[2] += w[k][0].z * bflo(rw.y); a[3] += w[k][0].w * bfhi(rw.y);
            a[4] += w[k][1].x * bflo(rw.z); a[5] += w[k][1].y * bfhi(rw.z); a[6] += w[k][1].z * bflo(rw.w); a[7] += w[k][1].w * bfhi(rw.w); }
#pragma unroll
        for (int j = 0; j < 8; ++j) val[o][j] = siluf(a[j]);
    }
}
__device__ __forceinline__ void bc_conv_prepass(Frame& F, const float* conv_w, const float* conv_b) {
    bf16* XBC = (bf16*)(F.ws + WS_BIG); const bf16* HALO = (const bf16*)(F.ws + WS_HALO);
    const int lane = lane_id(), run = F.wave;
    for (int it = F.vcu; it < 256; it += F.G) {
        const int chunk = it >> 1, half = it & 1, col = 2048 + half * 512 + 8 * lane;
        f32x4 w[4][2];
#pragma unroll
        for (int k = 0; k < 4; ++k) { w[k][0] = *(const GAS f32x4*)(conv_w + (size_t)k * CONVD + col); w[k][1] = *(const GAS f32x4*)(conv_w + (size_t)k * CONVD + col + 4); }
        const f32x4 b0 = *(const GAS f32x4*)(conv_b + col), b1 = *(const GAS f32x4*)(conv_b + col + 4);
        v4u raw[19];
#pragma unroll
        for (int i = 0; i < 19; ++i) { const int tt = 16 * run - 3 + i;
            if (tt >= 0) raw[i] = *(const GAS v4u*)(XBC + ((size_t)chunk * 128 + tt) * CONVD + col);
            else raw[i] = (chunk & 31) ? *(const GAS v4u*)(HALO + ((size_t)(chunk - 1) * 3 + (tt + 3)) * 1024 + (col - 2048)) : (v4u){0u, 0u, 0u, 0u}; }
        asm volatile("s_waitcnt vmcnt(0)" ::: "memory");
        __syncthreads();
#pragma unroll
        for (int o = 0; o < 16; ++o) {
            float a[8] = {b0.x, b0.y, b0.z, b0.w, b1.x, b1.y, b1.z, b1.w};
#pragma unroll
            for (int k = 0; k < 4; ++k) { const v4u rw = raw[o + k];
                a[0] += w[k][0].x * bflo(rw.x); a[1] += w[k][0].y * bfhi(rw.x); a[2] += w[k][0].z * bflo(rw.y); a[3] += w[k][0].w * bfhi(rw.y);
                a[4] += w[k][1].x * bflo(rw.z); a[5] += w[k][1].y * bfhi(rw.z); a[6] += w[k][1].z * bflo(rw.w); a[7] += w[k][1].w * bfhi(rw.w); }
            *(GAS v4u*)(XBC + ((size_t)chunk * 128 + 16 * run + o) * CONVD + col) = (v4u){pk2(siluf(a[0]), siluf(a[1])), pk2(siluf(a[2]), siluf(a[3])), pk2(siluf(a[4]), siluf(a[5])), pk2(siluf(a[6]), siluf(a[7]))};
        }
    }
}

constexpr int SO_CS = 0, SO_BS = 34816, SO_BDT = 69632, SO_XT = 104448, SO_HT = 121856, SO_XS = 139264, SO_TAB = 157696;
__device__ __forceinline__ void ssd_chain(Frame& F, int b, int h, const float* conv_w, const float* conv_b, const float* a_log, const float* d_skip) {
    const int g = h >> 3, lane = lane_id(), wave = F.wave, tid = wave * 64 + lane, r32 = lane & 31, hh = lane >> 5;
    LAS unsigned char* L = F.lds;
    const bf16* XBC = (const bf16*)(F.ws + WS_BIG); const bf16* Z = (const bf16*)F.out; const float* DT = (const float*)(F.ws + WS_DT);
    bf16* YA = (bf16*)(F.ws + WS_YA); float* PSSQ = (float*)(F.ws + WS_PSSQ);
    const float A_h = -__expf(a_log[h]), D_h = d_skip[h];
    const int bc_chunk = tid & 15, bc_s0 = 4 * (tid >> 4);
    const int x_chunk = tid & 7, x_s0 = 2 * (tid >> 3);
    const int e_l = tid >> 2, e_pc = tid & 3, e_p0 = 16 * e_pc;
    const int xcol = h * 64 + 8 * x_chunk;
    const bf16* pB = XBC + ((size_t)b * SEQ + bc_s0) * CONVD + 2048 + g * 128 + 8 * bc_chunk;
    const bf16* pX = XBC + ((size_t)b * SEQ + x_s0) * CONVD + xcol;
    const bf16* pZ = Z + ((size_t)b * SEQ + e_l) * DI + h * 64 + e_p0;
    const float* pDT = DT + ((size_t)b * SEQ + 2 * lane) * 32 + h;
    v4u bq[4], cq[4], xr[5]; float dn0 = 0.f, dn1 = 0.f;
#define SSD_LOADS(cc) do { const int t0_ = (cc) * CHUNK; \
        _Pragma("unroll") for (int o = 0; o < 4; ++o) { bq[o] = *(const GAS v4u*)(pB + (size_t)(t0_ + o) * CONVD); cq[o] = *(const GAS v4u*)(pB + (size_t)(t0_ + o) * CONVD + 512); } \
        _Pragma("unroll") for (int i = 0; i < 5; ++i) { const int tr_ = t0_ + x_s0 - 3 + i; xr[i] = (tr_ >= 0) ? *(const GAS v4u*)(pX + (ptrdiff_t)(t0_ - 3 + i) * CONVD) : (v4u){0u, 0u, 0u, 0u}; } \
        if (wave == 0) { dn0 = pDT[(size_t)t0_ * 32]; dn1 = pDT[(size_t)t0_ * 32 + 32]; } } while (0)
#define SSD_TABLES(tabp) do { if (wave == 0) { LAS float* acs_ = (tabp); const float a0 = dn0 * A_h, a1 = dn1 * A_h, sp_ = a0 + a1; float incl = sp_; \
        _Pragma("unroll") for (int o = 1; o < 64; o <<= 1) { const float t_ = __shfl_up(incl, o); if (lane >= o) incl += t_; } \
        const float c0 = incl - sp_ + a0, c1 = incl, tot = __shfl(incl, 63); \
        acs_[2 * lane] = c0; acs_[2 * lane + 1] = c1; acs_[128 + 2 * lane] = dn0; acs_[128 + 2 * lane + 1] = dn1; \
        acs_[256 + 2 * lane] = __expf(c0); acs_[256 + 2 * lane + 1] = __expf(c1); acs_[384 + 2 * lane] = __expf(tot - c0); acs_[384 + 2 * lane + 1] = __expf(tot - c1); } } while (0)
    SSD_LOADS(0);
    SSD_TABLES((LAS float*)(L + SO_TAB));
    f32x16 Hst = {};
    __syncthreads();
#pragma unroll 1
    for (int c = 0; c < NCHUNK; ++c) {
        const int t0 = c * CHUNK; const size_t rowbase = (size_t)b * SEQ + t0;
        LAS float* acs = (LAS float*)(L + SO_TAB + (c & 1) * 2048); LAS float* dtv = acs + 128; LAS float* eacs = acs + 256; LAS float* dend = acs + 384;
        const v4u zz0 = *(const GAS v4u*)(pZ + (size_t)t0 * DI), zz1 = *(const GAS v4u*)(pZ + (size_t)t0 * DI + 8);
        f32x4 xw[4][2];
#pragma unroll
        for (int k = 0; k < 4; ++k) { xw[k][0] = *(const GAS f32x4*)(conv_w + (size_t)k * CONVD + xcol); xw[k][1] = *(const GAS f32x4*)(conv_w + (size_t)k * CONVD + xcol + 4); }
        const f32x4 xb0 = *(const GAS f32x4*)(conv_b + xcol), xb1 = *(const GAS f32x4*)(conv_b + xcol + 4);
        {   const f32x4 de = *(const LAS f32x4*)(dend + bc_s0);
#pragma unroll
            for (int o = 0; o < 4; ++o) { *(LAS v4u*)(L + SO_CS + (bc_s0 + o) * 272 + bc_chunk * 16) = cq[o]; *(LAS v4u*)(L + SO_BS + (bc_s0 + o) * 272 + bc_chunk * 16) = bq[o]; }
            const unsigned bw[4][4] = {{bq[0].x, bq[0].y, bq[0].z, bq[0].w}, {bq[1].x, bq[1].y, bq[1].z, bq[1].w}, {bq[2].x, bq[2].y, bq[2].z, bq[2].w}, {bq[3].x, bq[3].y, bq[3].z, bq[3].w}};
#pragma unroll
            for (int jw = 0; jw < 4; ++jw) {
                *(LAS v2u*)(L + SO_BDT + (8 * bc_chunk + 2 * jw) * 272 + bc_s0 * 2) = (v2u){pk2(bflo(bw[0][jw]) * de.x, bflo(bw[1][jw]) * de.y), pk2(bflo(bw[2][jw]) * de.z, bflo(bw[3][jw]) * de.w)};
                *(LAS v2u*)(L + SO_BDT + (8 * bc_chunk + 2 * jw + 1) * 272 + bc_s0 * 2) = (v2u){pk2(bfhi(bw[0][jw]) * de.x, bfhi(bw[1][jw]) * de.y), pk2(bfhi(bw[2][jw]) * de.z, bfhi(bw[3][jw]) * de.w)}; }
        }
        __syncthreads();
        const int st = wave >> 1, lt0 = 2 * (wave & 1);
        f32x16 cb0 = {}, cb1 = {};
        cb0 = mma_lds(cb0, L + SO_BS + 32 * st * 272, L + SO_CS + 32 * lt0 * 272, 8, lane);
        cb1 = mma_lds(cb1, L + SO_BS + 32 * st * 272, L + SO_CS + 32 * (lt0 + 1) * 272, 8, lane);
        __syncthreads();
#pragma unroll
        for (int i = 0; i < 2; ++i) { const int l_ = 32 * (lt0 + i) + r32; const float el = acs[l_];
#pragma unroll
            for (int q = 0; q < 4; ++q) { const int sb = 32 * st + 8 * q + 4 * hh; const f32x4 as4 = *(const LAS f32x4*)(acs + sb); float mv[4];
#pragma unroll
                for (int jj = 0; jj < 4; ++jj) { const float cv = (i == 0) ? cb0[4 * q + jj] : cb1[4 * q + jj]; mv[jj] = (l_ >= sb + jj) ? cv * __expf(fminf(el - as4[jj], 0.f)) : 0.f; }
                *(LAS v2u*)(L + SO_BS + l_ * 272 + sb * 2) = (v2u){pk2(mv[0], mv[1]), pk2(mv[2], mv[3])}; } }
        {
            const int nt = wave >> 1, pt = wave & 1, p_ = 32 * pt + r32;
#pragma unroll
            for (int q = 0; q < 4; ++q) { const int nb = 32 * nt + 8 * q + 4 * hh;
                *(LAS v2u*)(L + SO_HT + p_ * 272 + nb * 2) = (v2u){pk2(Hst[4 * q], Hst[4 * q + 1]), pk2(Hst[4 * q + 2], Hst[4 * q + 3])}; } }
        {   float val[2][8];
#pragma unroll
            for (int o = 0; o < 2; ++o) {
                float a[8] = {xb0.x, xb0.y, xb0.z, xb0.w, xb1.x, xb1.y, xb1.z, xb1.w};
#pragma unroll
                for (int k = 0; k < 4; ++k) { const v4u rw = xr[o + k];
                    a[0] += xw[k][0].x * bflo(rw.x); a[1] += xw[k][0].y * bfhi(rw.x); a[2] += xw[k][0].z * bflo(rw.y); a[3] += xw[k][0].w * bfhi(rw.y);
                    a[4] += xw[k][1].x * bflo(rw.z); a[5] += xw[k][1].y * bfhi(rw.z); a[6] += xw[k][1].z * bflo(rw.w); a[7] += xw[k][1].w * bfhi(rw.w); }
#pragma unroll
                for (int j = 0; j < 8; ++j) val[o][j] = siluf(a[j]);
                *(LAS v4u*)(L + SO_XS + (x_s0 + o) * 144 + x_chunk * 16) = (v4u){pk2(val[o][0], val[o][1]), pk2(val[o][2], val[o][3]), pk2(val[o][4], val[o][5]), pk2(val[o][6], val[o][7])};
            }
            const float d0 = dtv[x_s0], d1 = dtv[x_s0 + 1];
#pragma unroll
            for (int j = 0; j < 8; ++j) *(LAS unsigned*)(L + SO_XT + (8 * x_chunk + j) * 272 + x_s0 * 2) = pk2(val[0][j] * d0, val[1][j] * d1);
        }
        if (c + 1 < NCHUNK) SSD_LOADS(c + 1);
        __syncthreads();
        const int lt = wave >> 1, pt = wave & 1;
        f32x16 y = {};
        y = mma_lds(y, L + SO_CS + 32 * lt * 272, L + SO_HT + 32 * pt * 272, 8, lane);
#pragma unroll
        for (int q = 0; q < 4; ++q) { const f32x4 e4 = *(const LAS f32x4*)(eacs + 32 * lt + 8 * q + 4 * hh);
            y[4 * q] *= e4.x; y[4 * q + 1] *= e4.y; y[4 * q + 2] *= e4.z; y[4 * q + 3] *= e4.w; }
        y = mma_lds(y, L + SO_BS + 32 * lt * 272, L + SO_XT + 32 * pt * 272, 2 * (lt + 1), lane);
        {   const float etot = eacs[127];
#pragma unroll
            for (int r = 0; r < 16; ++r) Hst[r] *= etot;
            Hst = mma_lds(Hst, L + SO_BDT + 32 * lt * 272, L + SO_XT + 32 * pt * 272, 8, lane); }
        if (c + 1 < NCHUNK) SSD_TABLES((LAS float*)(L + SO_TAB + ((c + 1) & 1) * 2048));
        __syncthreads();
#pragma unroll
        for (int r = 0; r < 16; ++r) *(LAS float*)(L + SO_CS + (32 * lt + rowidx(r, hh)) * 272 + (32 * pt + r32) * 4) = y[r];
        __syncthreads();
        {   const size_t row = rowbase + e_l;
            const v4u xx0 = *(const LAS v4u*)(L + SO_XS + e_l * 144 + e_p0 * 2), xx1 = *(const LAS v4u*)(L + SO_XS + e_l * 144 + e_p0 * 2 + 16);
            float yv[16], xv[16], zv[16];
#pragma unroll
            for (int i = 0; i < 4; ++i) { const f32x4 t = *(const LAS f32x4*)(L + SO_CS + e_l * 272 + (e_p0 + 4 * i) * 4); yv[4 * i] = t.x; yv[4 * i + 1] = t.y; yv[4 * i + 2] = t.z; yv[4 * i + 3] = t.w; }
            const unsigned xw_[8] = {xx0.x, xx0.y, xx0.z, xx0.w, xx1.x, xx1.y, xx1.z, xx1.w}, zw[8] = {zz0.x, zz0.y, zz0.z, zz0.w, zz1.x, zz1.y, zz1.z, zz1.w};
#pragma unroll
            for (int i = 0; i < 8; ++i) { xv[2 * i] = bflo(xw_[i]); xv[2 * i + 1] = bfhi(xw_[i]); zv[2 * i] = bflo(zw[i]); zv[2 * i + 1] = bfhi(zw[i]); }
            float gv[16], ss = 0.f;
#pragma unroll
            for (int i = 0; i < 16; ++i) { gv[i] = (yv[i] + D_h * xv[i]) * siluf(zv[i]); ss += gv[i] * gv[i]; }
            bf16* yo = YA + row * 3072 + h * 64 + e_p0;
            *(GAS v4u*)yo = (v4u){pk2(gv[0], gv[1]), pk2(gv[2], gv[3]), pk2(gv[4], gv[5]), pk2(gv[6], gv[7])};
            *(GAS v4u*)(yo + 8) = (v4u){pk2(gv[8], gv[9]), pk2(gv[10], gv[11]), pk2(gv[12], gv[13]), pk2(gv[14], gv[15])};
            ss += __shfl_xor(ss, 1); ss += __shfl_xor(ss, 2);
            if (e_pc == 0) PSSQ[row * 32 + h] = ss;
        }
        __syncthreads();
    }
#undef SSD_LOADS
#undef SSD_TABLES
}

__device__ __forceinline__ s16x4 vtr(const LAS unsigned char* p) { typedef short v4i16_t __attribute__((ext_vector_type(4))); return __builtin_bit_cast(s16x4, __builtin_amdgcn_ds_read_tr16_b64_v4i16((LAS v4i16_t*)p)); }
constexpr int AO_KV = 0, KV_RS = 144, AO_BIAS = 110592, BIAS_G = 200, AO_OST = 113152, OST_BYTES = 4608;
struct AttnTile { int gi, dsh, nrows, res0, kp0, m0w, rbw; };
__device__ __forceinline__ AttnTile attn_tile(int w, int span, int wave) {
    AttnTile t; t.gi = w >> 2; const int j = w & 3; t.dsh = 2 * t.gi;
    if (t.gi == 0) { const int M0 = span * 1024 + 256 * j; t.nrows = 384; t.res0 = 0; t.kp0 = M0 - 128; t.m0w = M0 + 32 * wave; t.rbw = 32 * wave; }
    else if (t.gi == 1) { const int M0 = span * 256; t.nrows = 384; t.res0 = j; t.kp0 = M0 - 128; t.m0w = M0 + 32 * wave; t.rbw = 32 * wave; }
    else { t.nrows = 768; t.res0 = 4 * j; t.kp0 = span * 64 - 128; t.m0w = span * 64 + 32 * (wave & 1); t.rbw = (wave >> 1) * 192 + 32 * (wave & 1); }
    return t;
}
#define ATT_STAGE_LOAD(regs, src, t) do { _Pragma("unroll") for (int i_ = 0; i_ < 12; ++i_) { const int ch_ = tid + 512 * i_, R_ = ch_ >> 3; \
        if (i_ < 6 || (t).gi == 2) { const int rr_ = ((t).gi == 2) ? R_ / 192 : 0, kq_ = (t).kp0 + (((t).gi == 2) ? R_ - 192 * rr_ : R_); const int kc_ = kq_ < 0 ? 0 : kq_; \
            regs[i_] = *(const GAS v4u*)((src) + ((size_t)b * SEQ + ((size_t)kc_ << (t).dsh) + (t).res0 + rr_) * D + h * 64 + 8 * (ch_ & 7)); } } } while (0)
#define ATT_STAGE_WRITE(regs, t) do { _Pragma("unroll") for (int i_ = 0; i_ < 12; ++i_) { const int ch_ = tid + 512 * i_; \
        if (i_ < 6 || (t).gi == 2) *(LAS v4u*)(F.lds + AO_KV + (ch_ >> 3) * KV_RS + (ch_ & 7) * 16) = regs[i_]; } } while (0)
__device__ __forceinline__ void attn_unit(Frame& F, int u, const float* rel_table) {
    const int b = u >> 6, h = (u >> 2) & 15, span = u & 3;
    bf16* Q = (bf16*)(F.ws + WS_BIG); const bf16* Kt = (const bf16*)F.out; const bf16* Vt = Kt + (size_t)T * D;
    float* LSE = (float*)(F.ws + WS_LSE); bf16* YA = (bf16*)(F.ws + WS_YA);
    const int lane = lane_id(), tid = F.wave * 64 + lane, r32 = lane & 31, hh = lane >> 5, lb = r32 - 4 * hh;
    __syncthreads();
    for (int i = tid; i < 3 * BIAS_G; i += NWAVES * 64) { const int gi = i / BIAS_G, dl = i % BIAS_G - 32; ((LAS float*)(F.lds + AO_BIAS))[i] = (dl >= 0 && dl <= 128) ? rel_table[(int)T5_BUCKET[gi][dl] * 48 + gi * 16 + h] : 0.f; }
    LAS unsigned char* ost = F.lds + AO_OST + F.wave * OST_BYTES;
    const int g4 = lane >> 4, q_ = (lane & 15) >> 2, p_ = lane & 3;
    v4u st[12];
    AttnTile tl = attn_tile(0, span, F.wave);
    ATT_STAGE_LOAD(st, Kt, tl);
#pragma unroll 1
    for (int w = 0; w < 12; ++w) {
        const int gi = tl.gi, dsh = tl.dsh, m0 = tl.m0w;
        const size_t qrow = (size_t)b * SEQ + ((size_t)(m0 + r32) << dsh) + tl.res0 + (gi == 2 ? (F.wave >> 1) : 0);
        const bf16* qp = Q + qrow * QW + gi * 1024 + h * 64 + hh * 8;
        bf16x8 qf[4];
#pragma unroll
        for (int s = 0; s < 4; ++s) qf[s] = *(const GAS bf16x8*)(qp + 16 * s);
        ATT_STAGE_WRITE(st, tl);
        __syncthreads();
        const LAS unsigned char* kbase = F.lds + AO_KV + (tl.rbw + r32) * KV_RS + hh * 16;
        f32x16 sc[5];
#pragma unroll
        for (int kb = 0; kb < 5; ++kb) { f32x16 acc = {};
#pragma unroll
            for (int s = 0; s < 4; ++s) { const bf16x8 kf = *(const LAS bf16x8*)(kbase + (32 * kb) * KV_RS + 32 * s); acc = __builtin_amdgcn_mfma_f32_32x32x16_bf16(kf, qf[s], acc, 0, 0, 0); }
            sc[kb] = acc; }
        ATT_STAGE_LOAD(st, Vt, tl);
        const LAS float* bt = (const LAS float*)(F.lds + AO_BIAS) + gi * BIAS_G + 32 + 128 + lb;
        float mx = -INFINITY;
#pragma unroll
        for (int kb = 0; kb < 5; ++kb) { const bool bneg = (m0 - 128 + 32 * kb) < 0;
#pragma unroll
            for (int r = 0; r < 16; ++r) { const int cr = (r & 3) + 8 * (r >> 2);
                float v = sc[kb][r] * 0.125f + bt[-(32 * kb + cr)];
                if (kb == 0) v = (lb <= cr) ? v : -INFINITY;
                if (kb == 4) v = (lb >= cr) ? v : -INFINITY;
                v = bneg ? -INFINITY : v;
                sc[kb][r] = v; mx = fmaxf(mx, v); } }
        mx = fmaxf(mx, __shfl_xor(mx, 32));
        float lsum = 0.f; unsigned pw[5][8];
#pragma unroll
        for (int kb = 0; kb < 5; ++kb)
#pragma unroll
            for (int r = 0; r < 16; r += 2) { const float p0 = fexp(sc[kb][r] - mx), p1 = fexp(sc[kb][r + 1] - mx); lsum += p0 + p1; pw[kb][r >> 1] = pk2(p0, p1); }
        lsum += __shfl_xor(lsum, 32);
        asm volatile("s_waitcnt lgkmcnt(0)" ::: "memory");
        __syncthreads();
        ATT_STAGE_WRITE(st, tl);
        __syncthreads();
        AttnTile tn = attn_tile(w + 1 < 12 ? w + 1 : 11, span, F.wave);
        if (w + 1 < 12) ATT_STAGE_LOAD(st, Kt, tn);
        f32x16 o0 = {}, o1 = {};
        const LAS unsigned char* trb = F.lds + AO_KV + (tl.rbw + 4 * (g4 >> 1) + q_) * KV_RS + (16 * (g4 & 1) + 4 * p_) * 2;
#pragma unroll
        for (int kb = 0; kb < 5; ++kb) {
#pragma unroll
            for (int s = 0; s < 2; ++s) {
                const v4u pv4 = (v4u){pw[kb][4 * s], pw[kb][4 * s + 1], pw[kb][4 * s + 2], pw[kb][4 * s + 3]};
                const bf16x8 pa = __builtin_bit_cast(bf16x8, pv4);
#pragma unroll
                for (int db = 0; db < 2; ++db) {
                    const s16x4 lo = vtr(trb + (32 * kb + 16 * s) * KV_RS + db * 64), hi = vtr(trb + (32 * kb + 16 * s + 8) * KV_RS + db * 64);
                    const bf16x8 vb = (bf16x8){lo[0], lo[1], lo[2], lo[3], hi[0], hi[1], hi[2], hi[3]};
                    if (db == 0) o0 = __builtin_amdgcn_mfma_f32_32x32x16_bf16(pa, vb, o0, 0, 0, 0); else o1 = __builtin_amdgcn_mfma_f32_32x32x16_bf16(pa, vb, o1, 0, 0, 0);
                }
            }
        }
        const float linv = 1.0f / lsum;
#pragma unroll
        for (int r = 0; r < 16; ++r) { const int q = rowidx(r, hh); const float li = __shfl(linv, q);
            *(LAS unsigned short*)(ost + q * 144 + r32 * 2) = (unsigned short)(pk2(o0[r] * li, 0.f) & 0xffffu); *(LAS unsigned short*)(ost + q * 144 + (32 + r32) * 2) = (unsigned short)(pk2(o1[r] * li, 0.f) & 0xffffu); }
        asm volatile("s_waitcnt lgkmcnt(0)" ::: "memory");
#pragma unroll
        for (int i = 0; i < 4; ++i) { const int cc = lane + 64 * i, q = cc >> 3, dc = cc & 7; const v4u v = *(const LAS v4u*)(ost + q * 144 + dc * 16);
            *(GAS v4u*)(Q + ((size_t)b * SEQ + ((size_t)(m0 + q) << dsh) + tl.res0 + (gi == 2 ? (F.wave >> 1) : 0)) * QW + gi * 1024 + h * 64 + 8 * dc) = v; }
        if (lane < 32) LSE[qrow * 48 + gi * 16 + h] = mx + __logf(lsum);
        asm volatile("s_waitcnt lgkmcnt(0)" ::: "memory");
        __syncthreads();
        tl = tn;
    }
    VM_WAIT();
    __syncthreads();
#pragma unroll 1
    for (int i = 0; i < 16; ++i) { const int it = tid + 512 * i, tok = it >> 3, dc = it & 7; const size_t row = (size_t)b * SEQ + span * 1024 + tok;
        const float l0 = LSE[row * 48 + h], l1 = LSE[row * 48 + 16 + h], l2 = LSE[row * 48 + 32 + h];
        const float mm = fmaxf(l0, fmaxf(l1, l2)); float w0 = __expf(l0 - mm), w1 = __expf(l1 - mm), w2 = __expf(l2 - mm); const float inv = 1.0f / (w0 + w1 + w2); w0 *= inv; w1 *= inv; w2 *= inv;
        const bf16* op = Q + row * QW + h * 64 + 8 * dc;
        const v4u a = *(const GAS v4u*)op, bq = *(const GAS v4u*)(op + 1024), cq = *(const GAS v4u*)(op + 2048);
        const unsigned aw[4] = {a.x, a.y, a.z, a.w}, bw[4] = {bq.x, bq.y, bq.z, bq.w}, cw[4] = {cq.x, cq.y, cq.z, cq.w}; unsigned ow[4];
#pragma unroll
        for (int j = 0; j < 4; ++j) ow[j] = pk2(w0 * bflo(aw[j]) + w1 * bflo(bw[j]) + w2 * bflo(cw[j]), w0 * bfhi(aw[j]) + w1 * bfhi(bw[j]) + w2 * bfhi(cw[j]));
        *(GAS v4u*)(YA + row * 3072 + 2048 + h * 64 + 8 * dc) = (v4u){ow[0], ow[1], ow[2], ow[3]}; }
}
#undef ATT_STAGE_LOAD
#undef ATT_STAGE_WRITE
__device__ __forceinline__ void ynorm_phase(Frame& F, const float* norm_g) {
    bf16* YA = (bf16*)(F.ws + WS_YA); const float* PSSQ = (const float*)(F.ws + WS_PSSQ);
    const int gw = F.vcu * NWAVES + F.wave, NGW = F.G * NWAVES, lane = lane_id();
    for (int m = gw; m < T; m += NGW) {
        const float ps = lane < 32 ? PSSQ[(size_t)m * 32 + lane] : 0.f;
        const float rstd = frsq(wave_sum(ps) * (1.0f / DI) + EPS);
#pragma unroll
        for (int j = 0; j < 4; ++j) { const int k = 8 * lane + 512 * j; bf16* p = YA + (size_t)m * 3072 + k;
            const v4u v = *(const GAS v4u*)p; const f32x4 g0 = *(const GAS f32x4*)(norm_g + k), g1 = *(const GAS f32x4*)(norm_g + k + 4);
            *(GAS v4u*)p = (v4u){pk2(bflo(v.x) * rstd * g0.x, bfhi(v.x) * rstd * g0.y), pk2(bflo(v.y) * rstd * g0.z, bfhi(v.y) * rstd * g0.w),
                                 pk2(bflo(v.z) * rstd * g1.x, bfhi(v.z) * rstd * g1.y), pk2(bflo(v.w) * rstd * g1.z, bfhi(v.w) * rstd * g1.w)}; }
    }
}

__device__ __forceinline__ void dwconv_phase(Frame& F, const float* w_dw, const float* b_dw, const float* ln_g, const float* ln_b) {
    const bf16* U = (const bf16*)(F.ws + WS_U); bf16* V2 = (bf16*)(F.ws + WS_V2);
    const int lane = lane_id(), tid = F.wave * 64 + lane;
    const int c0 = 2 * tid;
    float w0[31], w1[31];
#pragma unroll
    for (int k = 0; k < 31; ++k) { const float2 t = *(const float2*)(w_dw + (size_t)k * D + c0); w0[k] = t.x; w1[k] = t.y; }
    const float2 bb = *(const float2*)(b_dw + c0), lg = *(const float2*)(ln_g + c0), lb = *(const float2*)(ln_b + c0);
    LAS float* red = (LAS float*)F.lds;
    LAS float* tot = red + 256;
    const int sidx = (int)(__builtin_bitreverse32((unsigned)(lane & 31)) >> 27);
#pragma unroll 1
    for (int u = F.vcu; u < T / 16; u += F.G) {
        const int trow = u * 16, tb = trow & (SEQ - 1);
        float a0[16], a1[16];
#pragma unroll
        for (int o = 0; o < 16; ++o) { a0[o] = bb.x; a1[o] = bb.y; }
#pragma unroll
        for (int r = 0; r < 46; ++r) {
            unsigned raw = 0u;
            if (tb - 30 + r >= 0) raw = *(const GAS unsigned*)(U + (size_t)(trow - 30 + r) * D + c0);
            const float v0 = bflo(raw), v1 = bfhi(raw);
#pragma unroll
            for (int o = 0; o < 16; ++o) { const int k = r - o; if (k >= 0 && k <= 30) { a0[o] += w0[k] * v0; a1[o] += w1[k] * v1; } }
        }
        float v[32];
#pragma unroll
        for (int o = 0; o < 16; ++o) { v[o] = a0[o] + a1[o]; v[16 + o] = a0[o] * a0[o] + a1[o] * a1[o]; }
#define DW_STEP(k, half) { const bool up = (lane >> (k)) & 1; \
            _Pragma("unroll") for (int i = 0; i < (half); ++i) { const float send = up ? v[i] : v[i + (half)], keep = up ? v[i + (half)] : v[i]; v[i] = keep + swz_xor<(1 << (k))>(send); } }
        DW_STEP(0, 16) DW_STEP(1, 8) DW_STEP(2, 4) DW_STEP(3, 2) DW_STEP(4, 1)
#undef DW_STEP
        const float tv = v[0] + __shfl_xor(v[0], 32);
        __syncthreads();
        if (lane < 32) red[F.wave * 32 + sidx] = tv;
        __syncthreads();
        if (tid < 32) { float s = 0.f;
#pragma unroll
            for (int w8 = 0; w8 < 8; ++w8) s += red[w8 * 32 + tid];
            tot[tid] = s; }
        __syncthreads();
#pragma unroll
        for (int o = 0; o < 16; ++o) { const float mean = tot[o] * (1.0f / D), var = tot[16 + o] * (1.0f / D) - mean * mean; const float rstd = frsq(fmaxf(var, 0.f) + EPS);
            const float y0 = (a0[o] - mean) * rstd * lg.x + lb.x, y1 = (a1[o] - mean) * rstd * lg.y + lb.y;
            *(GAS unsigned*)(V2 + (size_t)(trow + o) * D + c0) = pk2(siluf(y0), siluf(y1)); }
    }
}

struct Args { const float* in[27]; float* out; unsigned char* ws; int ph_lo, ph_hi; };
__global__ void __launch_bounds__(NWAVES * 64, 2) mega_fwd(Args args) {
    extern __shared__ __attribute__((aligned(16))) unsigned char lds[];
    Frame F;
    F.lds = (LAS unsigned char*)lds;
    F.wave = __builtin_amdgcn_readfirstlane(threadIdx.x >> 6);
    F.G = gridDim.x; { const int bx = blockIdx.x; F.vcu = (F.G % 8 == 0) ? (bx % 8) * (F.G / 8) + bx / 8 : bx; }
    F.ws = args.ws; F.out = args.out; F.in = nullptr;
    volatile LAS unsigned* MISC = (volatile LAS unsigned*)(F.lds + MISC_OFF);
    if (threadIdx.x < 64) ((LAS unsigned*)(F.lds + MISC_OFF))[threadIdx.x] = 0u;
    __syncthreads();
    gu32* ctl = (gu32*)(F.ws + WS_CTL);
    XcdBarrier bar = xcd_barrier_post((unsigned*)(ctl + CW_BAR), MISC + 8, threadIdx.x == 0);
    const int lo = args.ph_lo, hi = args.ph_hi;
#define IN(k) (lo <= (k) && (k) < hi)
#ifdef PROBE_MASK
    unsigned long long pr_sum = 0ull, pr_t0 = 0ull;
#define PR_BEGIN(k) do { if ((PROBE_MASK >> (k)) & 1) pr_t0 = __builtin_amdgcn_s_memrealtime(); } while (0)
#define PR_END(k) do { if ((PROBE_MASK >> (k)) & 1) pr_sum += __builtin_amdgcn_s_memrealtime() - pr_t0; } while (0)
#else
#define PR_BEGIN(k) do {} while (0)
#define PR_END(k) do {} while (0)
#endif
#define SEAM(k) do { if (IN(k) && IN((k) + 1)) xcd_barrier(bar, F.wave); PR_END(k); PR_BEGIN((k) + 1); } while (0)
    PR_BEGIN(0);
    const float* x = args.in[0]; const float* MOD = (const float*)(F.ws + WS_MOD);
    const float* MOD0 = MOD; const float* MOD1 = MOD + 4 * 6144;
    LAS float* cscr = (LAS float*)(F.lds + F.wave * 8704);
    const int gw = F.vcu * NWAVES + F.wave, NGW = F.G * NWAVES;
    pg8::StaticOrder S;

    if (IN(0)) { p0_phase(F, args.in[1], args.in[2], args.in[3], args.in[6]); } SEAM(0);
    if (IN(1)) { p1_phase(F, x, args.in[4], args.in[9]); } SEAM(1);
    if (IN(2)) {
        pg8::Gemm g{(const bf16*)(F.ws + WS_H), (const bf16*)(F.ws + WS_WZX), T, 5120, D}; S.init(T, 5120, F.G, (int)blockIdx.x);
        pg8::EpiBf16Seg E{(bf16*)F.out, DI, 8, (bf16*)(F.ws + WS_BIG), CONVD, 1 << 30, nullptr, 0, (bf16*)(F.ws + WS_HALO)};
        pg8::gemm_phase<pg8::EpiBf16Seg, pg8::StaticOrder, true, true>(F.lds, F.wave, g, S, E);
    } SEAM(2);
    if (IN(3)) {
        bc_conv_prepass(F, args.in[7], args.in[8]);
        xcd_barrier(bar, F.wave);
        if ((F.vcu & 1) == 0) { for (int u = F.vcu >> 1; u < NB * NH; u += (F.G + 1) / 2) ssd_chain(F, u >> 5, u & 31, args.in[7], args.in[8], args.in[10], args.in[11]); }
        else { const int cw = (F.vcu >> 1) * NWAVES + F.wave, ncw = (F.G / 2) * NWAVES;
            for (int it = cw; it < 160 * 16; it += ncw) cvt_win_item(args.in[6], F.ws, it / 160, 161 + it % 160, cscr, lane_id()); }
    } SEAM(3);
    if (IN(4)) {
        pg8::Gemm g{(const bf16*)(F.ws + WS_H), (const bf16*)(F.ws + WS_WQKV), T, 5120, D}; S.init(T, 5120, F.G, (int)blockIdx.x);
        pg8::EpiBf16Seg E{(bf16*)(F.ws + WS_BIG), QW, 12, (bf16*)F.out, D, 16, (bf16*)F.out + (size_t)T * D, D, nullptr};
        pg8::gemm_phase<pg8::EpiBf16Seg, pg8::StaticOrder, true, true>(F.lds, F.wave, g, S, E);
    } SEAM(4);
    if (IN(5)) {
        for (int u = F.vcu; u < 256; u += F.G) attn_unit(F, u, args.in[14]);
        ynorm_phase(F, args.in[12]);
        __syncthreads();
        constexpr int I_OUT = 48 * 32, I_GU = 16 * 88, I_DN = 44 * 32, I_C1 = 16 * 32, I_C2 = 16 * 32;
        constexpr int NIT = I_OUT + 2 * (2 * I_GU + I_DN) + 2 * I_C1 + I_C2;
        const float* wg = args.in[23]; const float* wu = args.in[24]; const float* wd = args.in[25];
        for (int it = gw; it < NIT; it += NGW) { int r = it;
            if (r < I_OUT) { cvt_plain_item(args.in[13], 3072, D, (bf16*)(F.ws + WS_WOUT), r, cscr, lane_id()); continue; } r -= I_OUT;
            if (r < I_GU) { cvt_pair_item(wg, D, FH, 0, FH, 0, (bf16*)(F.ws + WS_WGU0), r, cscr, lane_id()); continue; } r -= I_GU;
            if (r < I_GU) { cvt_pair_item(wu, D, FH, 0, FH, 1, (bf16*)(F.ws + WS_WGU0), r, cscr, lane_id()); continue; } r -= I_GU;
            if (r < I_DN) { cvt_plain_item(wd, FH, D, (bf16*)(F.ws + WS_WD0), r, cscr, lane_id()); continue; } r -= I_DN;
            if (r < I_GU) { cvt_pair_item(wg + (size_t)D * FH, D, FH, 0, FH, 0, (bf16*)(F.ws + WS_WGU1), r, cscr, lane_id()); continue; } r -= I_GU;
            if (r < I_GU) { cvt_pair_item(wu + (size_t)D * FH, D, FH, 0, FH, 1, (bf16*)(F.ws + WS_WGU1), r, cscr, lane_id()); continue; } r -= I_GU;
            if (r < I_DN) { cvt_plain_item(wd + (size_t)FH * D, FH, D, (bf16*)(F.ws + WS_WD1), r, cscr, lane_id()); continue; } r -= I_DN;
            if (r < I_C1) { cvt_pair_item(args.in[15], D, 2048, 0, 1024, 0, (bf16*)(F.ws + WS_WC1), r, cscr, lane_id()); continue; } r -= I_C1;
            if (r < I_C1) { cvt_pair_item(args.in[15], D, 2048, 1024, 1024, 1, (bf16*)(F.ws + WS_WC1), r, cscr, lane_id()); continue; } r -= I_C1;
            cvt_plain_item(args.in[21], D, D, (bf16*)(F.ws + WS_WC2), r, cscr, lane_id());
        }
    } SEAM(5);
    if (IN(6)) {
        pg8::Gemm g{(const bf16*)(F.ws + WS_YA), (const bf16*)(F.ws + WS_WOUT), T, D, 3072}; S.init(T, D, F.G, (int)blockIdx.x);
        pg8::EpiRes E{x, F.out, MOD0 + 2048, nullptr};
        pg8::gemm_phase<pg8::EpiRes, pg8::StaticOrder, true, true>(F.lds, F.wave, g, S, E);
    } SEAM(6);
    if (IN(7)) { norm_phase(F, F.out, args.in[5], MOD0 + 3072, MOD0 + 4096, (bf16*)(F.ws + WS_H1)); } SEAM(7);
    if (IN(8)) {
        pg8::Gemm g{(const bf16*)(F.ws + WS_H1), (const bf16*)(F.ws + WS_WGU0), T, 2 * FH, D}; S.init(T, 2 * FH, F.G, (int)blockIdx.x);
        pg8::EpiGate<0> E{(bf16*)(F.ws + WS_HID), FH, nullptr, nullptr};
        pg8::gemm_phase<pg8::EpiGate<0>, pg8::StaticOrder, true, true>(F.lds, F.wave, g, S, E);
    } SEAM(8);
    if (IN(9)) {
        pg8::Gemm g{(const bf16*)(F.ws + WS_HID), (const bf16*)(F.ws + WS_WD0), T, D, FH}; S.init(T, D, F.G, (int)blockIdx.x);
        pg8::EpiRes E{F.out, F.out, MOD0 + 5120, nullptr};
        pg8::gemm_phase<pg8::EpiRes, pg8::StaticOrder, true, true>(F.lds, F.wave, g, S, E);
    } SEAM(9);
    if (IN(10)) { norm_phase(F, F.out, args.in[4] + D, MOD1 + 0, MOD1 + 1024, (bf16*)(F.ws + WS_H1)); } SEAM(10);
    if (IN(11)) {
        pg8::Gemm g{(const bf16*)(F.ws + WS_H1), (const bf16*)(F.ws + WS_WC1), T, 2048, D}; S.init(T, 2048, F.G, (int)blockIdx.x);
        pg8::EpiGate<1> E{(bf16*)(F.ws + WS_U), D, args.in[16], args.in[16] + 1024};
        pg8::gemm_phase<pg8::EpiGate<1>, pg8::StaticOrder, true, true>(F.lds, F.wave, g, S, E);
    } SEAM(11);
    if (IN(12)) { dwconv_phase(F, args.in[17], args.in[18], args.in[19], args.in[20]); } SEAM(12);
    if (IN(13)) {
        pg8::Gemm g{(const bf16*)(F.ws + WS_V2), (const bf16*)(F.ws + WS_WC2), T, D, D}; S.init(T, D, F.G, (int)blockIdx.x);
        pg8::EpiRes E{F.out, F.out, MOD1 + 2048, args.in[22]};
        pg8::gemm_phase<pg8::EpiRes, pg8::StaticOrder, true, true>(F.lds, F.wave, g, S, E);
    } SEAM(13);
    if (IN(14)) { norm_phase(F, F.out, args.in[5] + D, MOD1 + 3072, MOD1 + 4096, (bf16*)(F.ws + WS_H1)); } SEAM(14);
    if (IN(15)) {
        pg8::Gemm g{(const bf16*)(F.ws + WS_H1), (const bf16*)(F.ws + WS_WGU1), T, 2 * FH, D}; S.init(T, 2 * FH, F.G, (int)blockIdx.x);
        pg8::EpiGate<0> E{(bf16*)(F.ws + WS_HID), FH, nullptr, nullptr};
        pg8::gemm_phase<pg8::EpiGate<0>, pg8::StaticOrder, true, true>(F.lds, F.wave, g, S, E);
    } SEAM(15);
    if (IN(16)) {
        pg8::Gemm g{(const bf16*)(F.ws + WS_HID), (const bf16*)(F.ws + WS_WD1), T, D, FH}; S.init(T, D, F.G, (int)blockIdx.x);
        pg8::EpiRes E{F.out, F.out, MOD1 + 5120, nullptr};
        pg8::gemm_phase<pg8::EpiRes, pg8::StaticOrder, true, true>(F.lds, F.wave, g, S, E);
    } SEAM(16);
    if (IN(17)) {
        const float* fg = args.in[26];
        for (int m = gw; m < T; m += NGW) {
            const int lane = lane_id(); GAS f32x4* xr = (GAS f32x4*)(F.out + (size_t)m * D) + lane; f32x4 v[4]; float s = 0.f;
#pragma unroll
            for (int j = 0; j < 4; ++j) { v[j] = xr[64 * j]; s += (v[j].x * v[j].x + v[j].y * v[j].y) + (v[j].z * v[j].z + v[j].w * v[j].w); }
            const float rstd = frsq(wave_sum(s) * (1.0f / D) + EPS);
#pragma unroll
            for (int j = 0; j < 4; ++j) xr[64 * j] = (v[j] * rstd) * ((const GAS f32x4*)fg)[lane + 64 * j];
        }
    }
#ifdef PROBE_MASK
    PR_END(17);
    if (blockIdx.x == 0 && F.wave == 0) { const unsigned long long t1 = __builtin_amdgcn_s_memrealtime(); while (__builtin_amdgcn_s_memrealtime() - t1 < (unsigned long long)PROBE_MULT * pr_sum) __builtin_amdgcn_s_sleep(8); }
#endif
#undef IN
#undef SEAM
}

#ifndef MK_N_LAUNCHES
#define MK_N_LAUNCHES 1
#endif
extern "C" void kernel_launch(void* const* d_in, const int* in_sizes, int n_in, void* d_out, int out_size, void* d_ws, size_t ws_size, hipStream_t stream) {
    static int grid = 0;
    if (grid == 0) {
        if (n_in != 27 || in_sizes[0] != T * D || out_size != T * D || ws_size < WS_END) { fprintf(stderr, "kernel_launch: unexpected shapes (n_in %d, in0 %d, out %d, ws %zu); nothing launched\n", n_in, n_in > 0 ? in_sizes[0] : -1, out_size, ws_size); grid = -1; return; }
        int dev = 0, cus = 0, per_cu = 0;
        if (hipGetDevice(&dev) != hipSuccess || hipDeviceGetAttribute(&cus, hipDeviceAttributeMultiprocessorCount, dev) != hipSuccess) { grid = -1; return; }
        if (hipFuncSetAttribute((const void*)mega_fwd, hipFuncAttributeMaxDynamicSharedMemorySize, LDS_BYTES) != hipSuccess) { fprintf(stderr, "kernel_launch: hipFuncSetAttribute failed\n"); grid = -1; return; }
        if (hipOccupancyMaxActiveBlocksPerMultiprocessor(&per_cu, (const void*)mega_fwd, NWAVES * 64, LDS_BYTES) != hipSuccess || per_cu < 1)
            fprintf(stderr, "kernel_launch: note: occupancy query reports %d workgroups per CU\n", per_cu);
        (void)hipGetLastError();
        grid = cus;
    }
    if (grid < 0) return;
    if (hipMemsetAsync((char*)d_ws + WS_CTL, 0, CTL_ZERO_BYTES, stream) != hipSuccess) { fprintf(stderr, "kernel_launch: memset failed\n"); return; }
    Args a{};
    for (int i = 0; i < 27; ++i) a.in[i] = (const float*)d_in[i];
    a.out = (float*)d_out; a.ws = (unsigned char*)d_ws;
#if MK_N_LAUNCHES == 1
    a.ph_lo = 0; a.ph_hi = N_PHASES;
    hipLaunchKernelGGL(mega_fwd, dim3(grid), dim3(NWAVES * 64), LDS_BYTES, stream, a);
#else
    for (int p = 0; p < N_PHASES; ++p) { a.ph_lo = p; a.ph_hi = p + 1; hipLaunchKernelGGL(mega_fwd, dim3(grid), dim3(NWAVES * 64), LDS_BYTES, stream, a); }
#endif
    const hipError_t le = hipPeekAtLastError();
    if (le != hipSuccess) fprintf(stderr, "kernel_launch: launch failed: %s (grid %d)\n", hipGetErrorName(le), grid);
}
```
